# Optimizing an MI355X kernel written in HIP

```python
import jax, jax.numpy as jnp
from jax import lax
import numpy as np

D_MODEL = 1024
BATCH = 16
SEQ = 256
DEPTH = 4
DEC_BATCH = 8
DEC_SEQ = 4096
PAST_LEN = 256

GRID_W = 64
W_BR = 512
N_BRANCH = 3
H_A = 4
DK = 128
DV = 128
CONV_K = 3
DELTA_CHUNK = 64
G_B = 4
CH_B = W_BR // G_B
CHUNK_B = 128
G_C = 4
CH_C = W_BR // G_C
N_IN = 3 * W_BR + 4 * H_A + 6 * W_BR + N_BRANCH * D_MODEL
EPS = 1e-6

kernel_name = 'hybrid_delta_sgu_fourier_flow_step'


def rmsnorm(x, g):
    xf = x.astype(jnp.float32)
    y = xf * lax.rsqrt(jnp.mean(xf * xf, axis=-1, keepdims=True) + EPS)
    return (y * g.astype(jnp.float32)).astype(x.dtype)


def l2norm(x):
    return x * lax.rsqrt(jnp.sum(x * x, axis=-1, keepdims=True) + EPS)


def ada_mod(cvec, w, b):
    m = jnp.einsum('...d,de->...e', jax.nn.silu(cvec), w) + b
    return jnp.split(m, 3, axis=-1)


def short_conv(x, w):
    y = lax.conv_general_dilated(x, w[:, None, :].astype(x.dtype), window_strides=(1,),
                                 padding=((CONV_K // 2, CONV_K // 2),),
                                 dimension_numbers=('NWC', 'WIO', 'NWC'),
                                 feature_group_count=x.shape[-1])
    return jax.nn.silu(y)


def gated_delta_chunked(q, k, v, g, beta, s0):
    B, T, H, _ = q.shape
    n = T // DELTA_CHUNK

    def blk(t):
        t = t.reshape((B, n, DELTA_CHUNK) + t.shape[2:])
        return jnp.swapaxes(t, 2, 3)

    qc, kc, vc, gc, bc = blk(q), blk(k), blk(v), blk(g), blk(beta)
    gam = jnp.cumsum(gc, axis=-1)
    pos = jnp.arange(DELTA_CHUNK)
    strict = pos[:, None] > pos[None, :]
    incl = pos[:, None] >= pos[None, :]
    diff = gam[..., :, None] - gam[..., None, :]
    dec_strict = jnp.where(strict, jnp.exp(jnp.where(strict, diff, 0.0)), 0.0)
    dec_incl = jnp.where(incl, jnp.exp(jnp.where(incl, diff, 0.0)), 0.0)
    eye = jnp.eye(DELTA_CHUNK, dtype=q.dtype)
    m = eye + bc[..., :, None] * jnp.einsum('bnhik,bnhjk->bnhij', kc, kc) * dec_strict
    rhs = jnp.concatenate([vc * bc[..., None], kc * (bc * jnp.exp(gam))[..., None]], axis=-1)
    sol = lax.linalg.triangular_solve(m, rhs, left_side=True, lower=True, unit_diagonal=True)
    u0, w = sol[..., :DV], sol[..., DV:]
    qk = jnp.einsum('bnhik,bnhjk->bnhij', qc, kc) * dec_incl
    qg = qc * jnp.exp(gam)[..., None]
    kd = kc * jnp.exp(gam[..., -1:] - gam)[..., None]
    glast = jnp.exp(gam[..., -1])
    xs = tuple(jnp.moveaxis(t, 1, 0) for t in (u0, w, qk, qg, kd, glast))

    def step(s, inp):
        u0_, w_, qk_, qg_, kd_, gl_ = inp
        u = u0_ - jnp.einsum('bhck,bhkv->bhcv', w_, s)
        o = jnp.einsum('bhck,bhkv->bhcv', qg_, s) + jnp.einsum('bhij,bhjv->bhiv', qk_, u)
        s = gl_[..., None, None] * s + jnp.einsum('bhck,bhcv->bhkv', kd_, u)
        return s, o

    s_fin, o = lax.scan(step, s0, xs)
    o = jnp.transpose(o, (1, 0, 3, 2, 4)).reshape(B, T, H, DV)
    return o, s_fin


def delta_bidir(q, k, v, g, beta, s0_f, s0_b):
    o_f, s_f = gated_delta_chunked(q, k, v, g[:, :, 0], beta[:, :, 0], s0_f)
    rev = lambda t: jnp.flip(t, axis=1)
    o_b, s_b = gated_delta_chunked(rev(q), rev(k), rev(v), rev(g[:, :, 1]), rev(beta[:, :, 1]), s0_b)
    return o_f + rev(o_b), s_f, s_b


def chunk_sgu(u, v, g_norm, w_s, b_s):
    B, T, _ = u.shape
    n = T // CHUNK_B
    vn = rmsnorm(v, g_norm).reshape(B, n, CHUNK_B, G_B, CH_B)
    vs = jnp.einsum('gpq,bnqgc->bnpgc', w_s, vn) + b_s.T[None, None, :, :, None]
    return u * vs.reshape(B, T, W_BR)


def fourier_mix(xc, grid):
    B, T, _ = xc.shape
    xf = xc.astype(jnp.float32).reshape(B, T, G_C, CH_C)
    if grid is None:
        y = jnp.fft.fftn(xf, axes=(1, 3), norm='ortho').real
    else:
        rows, cols = grid
        y = jnp.fft.fftn(xf.reshape(B, rows, cols, G_C, CH_C), axes=(1, 2, 4), norm='ortho').real
    return y.reshape(B, T, W_BR).astype(xc.dtype)


def mixer(xn, w_in, conv_w, a_log, dt_bias, o_norm_g, sgu_norm_g, w_spatial, b_spatial,
          w_branch, w_out, s0_f, s0_b, grid):
    B, T, _ = xn.shape
    sizes = (3 * W_BR, 2 * H_A, 2 * H_A, W_BR, W_BR, W_BR, W_BR, W_BR, W_BR, N_BRANCH * D_MODEL)
    points = [int(p) for p in np.cumsum(sizes)[:-1]]
    proj = jnp.einsum('btd,de->bte', xn, w_in)
    qkv, beta, dec, z_a, u_b, v_b, z_b, x_c, z_c, gates = jnp.split(proj, points, axis=-1)

    qkv = short_conv(qkv, conv_w).astype(jnp.float32)
    q, k, v = jnp.split(qkv, 3, axis=-1)
    q = l2norm(q.reshape(B, T, H_A, DK)) * (DK ** -0.5)
    k = l2norm(k.reshape(B, T, H_A, DK))
    v = v.reshape(B, T, H_A, DV)
    beta = jax.nn.sigmoid(beta.astype(jnp.float32)).reshape(B, T, 2, H_A)
    g = -jnp.exp(a_log.astype(jnp.float32)) * jax.nn.softplus(
        dec.astype(jnp.float32).reshape(B, T, 2, H_A) + dt_bias.astype(jnp.float32))
    o, s_f, s_b = delta_bidir(q, k, v, g, beta, s0_f.astype(jnp.float32), s0_b.astype(jnp.float32))
    o = rmsnorm(o, o_norm_g) * jax.nn.silu(z_a.astype(jnp.float32).reshape(B, T, H_A, DV))
    o_a = o.reshape(B, T, W_BR).astype(xn.dtype)

    o_b = chunk_sgu(u_b, v_b, sgu_norm_g, w_spatial, b_spatial) * jax.nn.silu(z_b)

    o_c = fourier_mix(x_c, grid) * jax.nn.silu(z_c)

    br = jnp.stack([o_a, o_b, o_c], axis=2)
    pb = jnp.einsum('btnw,nwd->btnd', br, w_branch)
    gt = jax.nn.sigmoid(gates.reshape(B, T, N_BRANCH, D_MODEL))
    merged = jnp.einsum('btnd,btnd->btd', gt, pb)
    return jnp.einsum('btd,de->bte', merged, w_out), s_f, s_b


def setup_inputs(seed: int = 0) -> dict:
    key = jax.random.key(seed)
    ks = jax.random.split(key, 24)
    nrm = lambda k, s: jax.random.normal(k, s, jnp.float32)
    dt = jnp.exp(jax.random.uniform(ks[8], (DEPTH, 2, H_A), jnp.float32) * (np.log(0.1) - np.log(0.001)) + np.log(0.001))
    return {
        'x_prompt': nrm(ks[0], (BATCH, SEQ, D_MODEL)),
        'x_sample': nrm(ks[1], (DEC_BATCH, DEC_SEQ, D_MODEL)),
        'state_delta': 0.5 * nrm(ks[2], (DEC_BATCH, DEPTH, 2, H_A, DK, DV)),
        'c': nrm(ks[3], (DEC_BATCH, D_MODEL)),
        'c_ctx': nrm(ks[4], (D_MODEL,)),
        'ln_g': 1.0 + 0.05 * nrm(ks[5], (DEPTH, D_MODEL)),
        'w_ada': 0.5 * D_MODEL ** -0.5 * nrm(ks[6], (DEPTH, D_MODEL, 3 * D_MODEL)),
        'b_ada': 0.02 * nrm(ks[7], (DEPTH, 3 * D_MODEL)),
        'w_in': D_MODEL ** -0.5 * nrm(ks[9], (DEPTH, D_MODEL, N_IN)),
        'conv_w': CONV_K ** -0.5 * nrm(ks[10], (DEPTH, CONV_K, 3 * W_BR)),
        'a_log': jnp.log(jax.random.uniform(ks[11], (DEPTH, 2, H_A), jnp.float32, 1.0, 16.0)),
        'dt_bias': dt + jnp.log(-jnp.expm1(-dt)),
        'o_norm_g': 1.0 + 0.05 * nrm(ks[12], (DEPTH, DV)),
        'sgu_norm_g': 1.0 + 0.05 * nrm(ks[13], (DEPTH, W_BR)),
        'w_spatial': CHUNK_B ** -0.5 * nrm(ks[14], (DEPTH, G_B, CHUNK_B, CHUNK_B)),
        'b_spatial': 1.0 + 0.02 * nrm(ks[15], (DEPTH, G_B, CHUNK_B)),
        'w_branch': W_BR ** -0.5 * nrm(ks[16], (DEPTH, N_BRANCH, W_BR, D_MODEL)),
        'w_out': D_MODEL ** -0.5 * nrm(ks[17], (DEPTH, D_MODEL, D_MODEL)),
        'final_g': 1.0 + 0.05 * nrm(ks[18], (D_MODEL,)),
    }


def reference(x_prompt, x_sample, state_delta, c, c_ctx, ln_g, w_ada, b_ada, w_in, conv_w, a_log,
              dt_bias, o_norm_g, sgu_norm_g, w_spatial, b_spatial, w_branch, w_out, final_g):
    rows = x_sample.shape[1] // GRID_W

    def lp(l):
        return (w_in[l], conv_w[l], a_log[l], dt_bias[l], o_norm_g[l], sgu_norm_g[l],
                w_spatial[l], b_spatial[l], w_branch[l], w_out[l])

    h = x_prompt
    zeros = jnp.zeros((x_prompt.shape[0], H_A, DK, DV), jnp.float32)
    states = []
    for l in range(DEPTH):
        shift, scale, gate = ada_mod(c_ctx, w_ada[l], b_ada[l])
        xn = rmsnorm(h, ln_g[l]) * (1.0 + scale) + shift
        out, s_f, s_b = mixer(xn, *lp(l), zeros, zeros, None)
        h = h + gate * out
        states.append(jnp.stack([s_f, s_b], axis=1))
    y_prompt = rmsnorm(h, final_g)
    new_state_delta = jnp.stack(states, axis=1).astype(x_prompt.dtype)

    h = x_sample
    for l in range(DEPTH):
        shift, scale, gate = ada_mod(c, w_ada[l], b_ada[l])
        xn = rmsnorm(h, ln_g[l]) * (1.0 + scale[:, None, :]) + shift[:, None, :]
        out, _, _ = mixer(xn, *lp(l), state_delta[:, l, 0], state_delta[:, l, 1], (rows, GRID_W))
        h = h + gate[:, None, :] * out
    y_sample = rmsnorm(h, final_g)
    return (y_prompt, y_sample, new_state_delta)
```

```cpp
#include <hip/hip_runtime.h>
#include <hip/hip_cooperative_groups.h>
#include <cstdio>
namespace cg = cooperative_groups;

#define DI __device__ __forceinline__
#define LAS __attribute__((address_space(3)))
typedef unsigned short bf16_t;
typedef short bf16x8 __attribute__((ext_vector_type(8)));
typedef float f32x4 __attribute__((ext_vector_type(4)));
typedef unsigned u32x4 __attribute__((ext_vector_type(4)));
typedef unsigned u32x2 __attribute__((ext_vector_type(2)));

constexpr int DM = 1024, MCTX = 4096, MTOT = 36864, NLAYER = 4;
constexpr int N1 = 4864, NGATE = 3072, NIN = 7696;
constexpr float EPS = 1e-6f;
constexpr int NTHREADS = 512;
constexpr int LDS_BYTES = 147456;
#ifndef DUP_GEMM
#define DUP_GEMM 0
#endif
#ifndef DUP_CHAIN
#define DUP_CHAIN 0
#endif
#ifndef DUP_P0
#define DUP_P0 0
#endif
#ifndef DUP_BI
#define DUP_BI 0
#endif
#ifndef DUP_F3
#define DUP_F3 0
#endif

constexpr size_t RB = (size_t)MTOT * 512 * 2;
constexpr size_t OFF_MOD = 0;
constexpr size_t OFF_SW1 = 524288;
constexpr size_t OFF_SWG = 1310720;
constexpr size_t OFF_ROWSQ = 1835008;
constexpr size_t OFF_CTR = 1830912;
constexpr size_t OFF_BD = 2621440;
constexpr size_t OFF_GB = 5242880;
constexpr size_t OFF_HALO = 7864320;
constexpr size_t OFF_TAB = 11534336;
constexpr size_t TAB_FCH = 0, TAB_M2 = 65536, TAB_CS64 = 98304, TAB_CS256 = 114688;
constexpr size_t OFF_W1 = 12582912;
constexpr size_t OFF_WG = OFF_W1 + (size_t)N1 * 1024 * 2;
constexpr size_t OFF_WBR = OFF_WG + (size_t)NGATE * 1024 * 2;
constexpr size_t OFF_WOUT = OFF_WBR + (size_t)3 * 1024 * 512 * 2;
constexpr size_t OFF_X = OFF_WOUT + (size_t)1024 * 1024 * 2;
constexpr size_t OFF_Y = OFF_X + 2 * RB;
constexpr size_t OFF_G = OFF_Y + 2 * RB;
constexpr size_t OFF_QKV = OFF_G, OFF_TQ = OFF_G + 3 * RB, OFF_IM = OFF_G + 4 * RB, OFF_ZC = OFF_G + 5 * RB;
constexpr size_t OFF_ZA = OFF_G + 6 * RB, OFF_UBZ = OFF_ZA + RB, OFF_XC = OFF_UBZ + RB, OFF_SPARE = OFF_XC + RB, WS_END = OFF_SPARE + (size_t)MCTX * 512 * 2;

struct Params {
    const float* in[19];
    float* out;
    unsigned char* ws;
};

DI unsigned f2bf(float f) { const __bf16 b = (__bf16)f; return (unsigned)__builtin_bit_cast(unsigned short, b); }
typedef float f32x2_t __attribute__((ext_vector_type(2)));
typedef __bf16 bf16x2_t __attribute__((ext_vector_type(2)));
DI unsigned pk2(float lo, float hi) { const f32x2_t v = {lo, hi}; const bf16x2_t b = __builtin_convertvector(v, bf16x2_t); return __builtin_bit_cast(unsigned, b); }
DI float bflo(unsigned u) { return __builtin_bit_cast(float, u << 16); }
DI float bfhi(unsigned u) { return __builtin_bit_cast(float, u & 0xffff0000u); }
DI float bf2f(bf16_t h) { return __builtin_bit_cast(float, ((unsigned)h) << 16); }
DI float sigm(float x) { return __builtin_amdgcn_rcpf(1.0f + __expf(-x)); }
DI float silu(float x) { return x * sigm(x); }
DI float softplus(float x) { return fmaxf(x, 0.f) + log1pf(__expf(-fabsf(x))); }
DI int tid_opaque() { int t = threadIdx.x; asm volatile("" : "+v"(t)); return t; }
constexpr int PTAB_OFF = 147456 - 256;
DI void* ld_ptr(LAS unsigned char* lds, int i) {
    const volatile LAS unsigned* p = (const volatile LAS unsigned*)(lds + PTAB_OFF) + 2 * i;
    const unsigned lo = __builtin_amdgcn_readfirstlane(p[0]), hi = __builtin_amdgcn_readfirstlane(p[1]);
    return (void*)(((unsigned long long)hi << 32) | lo);
}
DI int bidx_of_row(int row) { return row < MCTX ? 0 : 1 + ((row - MCTX) >> 12); }

DI f32x4 mfma16(bf16x8 a, bf16x8 b, f32x4 c) { return __builtin_amdgcn_mfma_f32_16x16x32_bf16(a, b, c, 0, 0, 0); }
DI f32x4 mma_tile(f32x4 acc, const LAS bf16_t* A, int lda, const LAS bf16_t* Bt, int ldb, int K, int lane) {
    const int r = lane & 15, q = lane >> 4;
    const LAS bf16_t* ap = A + r * lda + q * 8;
    const LAS bf16_t* bp = Bt + r * ldb + q * 8;
    for (int k0 = 0; k0 < K; k0 += 32) {
        bf16x8 a = *(const LAS bf16x8*)(ap + k0);
        bf16x8 b = *(const LAS bf16x8*)(bp + k0);
        acc = mfma16(a, b, acc);
    }
    return acc;
}

namespace pg8 {
constexpr int BM = 256, BK = 64, HALF = 128, HTB = HALF * BK * 2, NXCD = 8, WGM = 8;
DI int lds_byte(int r, int c) { const int st = (r >> 4) * 2 + (c >> 5), rr = r & 15, cc = c & 31, ob = rr * 64 + cc * 2; return st * 1024 + (ob ^ (((ob >> 9) & 1) << 5)); }
DI void stage_rc(int b, int& R, int& C) { const int st = b / 1024, sb = b % 1024, swz = sb ^ (((sb >> 9) & 1) << 5); R = (st >> 1) * 16 + swz / 64; C = (st & 1) * 32 + (swz % 64) / 2; }
DI int perm32(int rho) { const int n = rho >> 4, i = rho & 15; return 8 * (i >> 2) + 4 * n + (i & 3); }
struct Unit { int pm, pn, br; };
struct Sched {
    int nM, nN, nwg, G, c, nsub, K;
    const char* A0; size_t asub; const char* B0; size_t bsub;
    DI bool next(int i, Unit& u) const {
        const int ib = i / nsub; u.br = i - ib * nsub;
        const long L = (long)ib * G + c; if (L >= nwg) return false;
        int wgid = (int)L; { const int q = nwg / NXCD, r = nwg % NXCD, xcd = wgid % NXCD, off = wgid / NXCD; wgid = (xcd < r ? xcd * (q + 1) : r * (q + 1) + (xcd - r) * q) + off; }
        const int nig = WGM * nN, gid = wgid / nig, fm = gid * WGM, gsz = (nM - fm) < WGM ? (nM - fm) : WGM;
        u.pm = fm + ((wgid % nig) % gsz); u.pn = (wgid % nig) / gsz; return true;
    }
    DI const char* aptr(const Unit& u) const { return A0 + (size_t)u.br * asub + (size_t)u.pm * (size_t)(BM * 2) * K; }
    DI const char* bptr(const Unit& u) const { return B0 + (size_t)u.br * bsub + (size_t)u.pn * (size_t)(BM * 2) * K; }
};
typedef f32x4 acc_t[2][2][4][2];

template <class Epi>
DI void gemm_phase(LAS unsigned char* lds, const Sched& S, const Epi& E) {
    const int tid = tid_opaque(), wid = __builtin_amdgcn_readfirstlane(tid >> 6), lane = tid & 63, wr = wid >> 2, wc = wid & 3, fr = lane & 15, fq = lane >> 4;
    const int K = S.K, nt = K / BK;
    unsigned voffA[2], voffB[2];
#pragma unroll
    for (int i = 0; i < 2; ++i) { int R, C; stage_rc(tid * 16 + i * 8192, R, C); const int Rb = (R & ~31) + perm32(R & 31);
        voffA[i] = (unsigned)(R * K + C) * 2u; voffB[i] = (unsigned)(Rb * K + C) * 2u; }
    const size_t kstep = (size_t)(BK * 2);
    const size_t hstep = (size_t)HALF * K * 2;
    const unsigned ldsw = (unsigned)wid * 1024u;
    const int aoff = lds_byte(wr * 64 + fr, fq * 8), boff = lds_byte(wc * 32 + fr, fq * 8);
#define PG8_SA(b, h) (((b) * 2 + (h)) * HTB)
#define PG8_SB(b, h) ((4 + (b) * 2 + (h)) * HTB)
#define PG8_STAGE(bufoff, gbase, voff) do { _Pragma("unroll") for (int _i = 0; _i < 2; ++_i) \
        __builtin_amdgcn_global_load_lds((const unsigned*)((const char*)(gbase) + (voff)[_i]), (LAS unsigned*)(lds + (bufoff) + ldsw + _i * 8192), 16, 0, 0); } while (0)
#define PG8_LDA(dst, b, h) do { _Pragma("unroll") for (int m = 0; m < 4; ++m) _Pragma("unroll") for (int k = 0; k < 2; ++k) dst[m][k] = *(const LAS bf16x8*)(lds + PG8_SA(b, h) + aoff + m * 2048 + k * 1024); } while (0)
#define PG8_LDB(dst, b, h) do { _Pragma("unroll") for (int n = 0; n < 2; ++n) _Pragma("unroll") for (int k = 0; k < 2; ++k) dst[n][k] = *(const LAS bf16x8*)(lds + PG8_SB(b, h) + boff + n * 2048 + k * 1024); } while (0)
#define PG8_MMA(ai, bj, At, Bt) do { __builtin_amdgcn_s_setprio(1); _Pragma("unroll") for (int m = 0; m < 4; ++m) _Pragma("unroll") for (int n = 0; n < 2; ++n) _Pragma("unroll") for (int k = 0; k < 2; ++k) \
        acc[ai][bj][m][n] = __builtin_amdgcn_mfma_f32_16x16x32_bf16(Bt[n][k], At[m][k], acc[ai][bj][m][n], 0, 0, 0); __builtin_amdgcn_s_setprio(0); } while (0)
#define PG8_WAIT_V(n) asm volatile("s_waitcnt vmcnt(" #n ")" ::: "memory")
#define PG8_WAIT_L(n) asm volatile("s_waitcnt lgkmcnt(" #n ")" ::: "memory")
#define PG8_BAR __builtin_amdgcn_s_barrier()
#define PG8_SCHED __builtin_amdgcn_sched_barrier(0)
    Unit cur, nxt; int ui = 0;
    if (!S.next(0, cur)) return;
    acc_t acc;
#pragma unroll
    for (int a = 0; a < 2; ++a)
#pragma unroll
        for (int b = 0; b < 2; ++b)
#pragma unroll
            for (int m = 0; m < 4; ++m)
#pragma unroll
                for (int n = 0; n < 2; ++n) acc[a][b][m][n] = (f32x4){0.f, 0.f, 0.f, 0.f};
    bf16x8 At[4][2], B0[2][2], B1[2][2];
    const char* cA = S.aptr(cur); const char* cB = S.bptr(cur);
    PG8_STAGE(PG8_SB(0, 0), cB, voffB); PG8_STAGE(PG8_SA(0, 0), cA, voffA); PG8_STAGE(PG8_SB(0, 1), cB + hstep, voffB); PG8_STAGE(PG8_SA(0, 1), cA + hstep, voffA);
    if (wr == 1) PG8_BAR;
    PG8_WAIT_V(4); PG8_BAR;
    PG8_STAGE(PG8_SB(1, 0), cB + kstep, voffB); PG8_STAGE(PG8_SA(1, 0), cA + kstep, voffA); PG8_STAGE(PG8_SB(1, 1), cB + hstep + kstep, voffB);
    PG8_WAIT_V(6); PG8_BAR;
    for (;;) {
        const bool has_next = S.next(ui + 1, nxt);
        const char* nA = has_next ? S.aptr(nxt) : cA; const char* nB = has_next ? S.bptr(nxt) : cB;
        for (int t = 0; t < nt; t += 2) {
            const bool last = (t == nt - 2);
            const char* a1 = cA + (size_t)(t + 1) * kstep;
            const char* a2 = last ? nA : cA + (size_t)(t + 2) * kstep; const char* b2 = last ? nB : cB + (size_t)(t + 2) * kstep;
            const char* a3 = a2 + kstep; const char* b3 = b2 + kstep;
            PG8_LDB(B0, 0, 0); PG8_SCHED; PG8_LDA(At, 0, 0); PG8_STAGE(PG8_SA(1, 1), a1 + hstep, voffA);
            PG8_WAIT_L(8); PG8_BAR; PG8_WAIT_L(0); PG8_MMA(0, 0, At, B0); PG8_BAR; PG8_SCHED;
            PG8_LDB(B1, 0, 1); PG8_STAGE(PG8_SB(0, 0), b2, voffB);
            PG8_BAR; PG8_WAIT_L(0); PG8_MMA(0, 1, At, B1); PG8_BAR;
            PG8_LDA(At, 0, 1); PG8_STAGE(PG8_SA(0, 0), a2, voffA);
            PG8_BAR; PG8_WAIT_L(0); PG8_MMA(1, 0, At, B0); PG8_BAR; PG8_SCHED;
            PG8_STAGE(PG8_SB(0, 1), b2 + hstep, voffB);
            PG8_WAIT_V(6); PG8_BAR; PG8_MMA(1, 1, At, B1); PG8_BAR;
            PG8_LDB(B0, 1, 0); PG8_SCHED; PG8_LDA(At, 1, 0); PG8_STAGE(PG8_SA(0, 1), a2 + hstep, voffA);
            PG8_WAIT_L(8); PG8_BAR; PG8_WAIT_L(0); PG8_MMA(0, 0, At, B0); PG8_BAR; PG8_SCHED;
            PG8_LDB(B1, 1, 1); PG8_STAGE(PG8_SB(1, 0), b3, voffB);
            PG8_BAR; PG8_WAIT_L(0); PG8_MMA(0, 1, At, B1); PG8_BAR;
            PG8_LDA(At, 1, 1); PG8_STAGE(PG8_SA(1, 0), a3, voffA);
            PG8_BAR; PG8_WAIT_L(0); PG8_MMA(1, 0, At, B0); PG8_BAR; PG8_SCHED;
            PG8_STAGE(PG8_SB(1, 1), b3 + hstep, voffB);
            PG8_WAIT_V(6); PG8_BAR; PG8_MMA(1, 1, At, B1); PG8_BAR;
        }
        E(acc, cur, wr, wc, fr, fq);
        if (!has_next) break;
#pragma unroll
        for (int a = 0; a < 2; ++a)
#pragma unroll
            for (int b = 0; b < 2; ++b)
#pragma unroll
                for (int m = 0; m < 4; ++m)
#pragma unroll
                    for (int n = 0; n < 2; ++n) acc[a][b][m][n] = (f32x4){0.f, 0.f, 0.f, 0.f};
        cur = nxt; cA = nA; cB = nB; ++ui;
    }
    PG8_WAIT_V(0);
    if (wr == 0) PG8_BAR;
    PG8_BAR;
#undef PG8_SA
#undef PG8_SB
#undef PG8_STAGE
#undef PG8_LDA
#undef PG8_LDB
#undef PG8_MMA
#undef PG8_WAIT_V
#undef PG8_WAIT_L
#undef PG8_BAR
#undef PG8_SCHED
}
}
using pg8::Unit;
using pg8::acc_t;

DI u32x4 pk8(f32x4 a, f32x4 b) { u32x4 w; w.x = pk2(a[0], a[1]); w.y = pk2(a[2], a[3]); w.z = pk2(b[0], b[1]); w.w = pk2(b[2], b[3]); return w; }
struct EpiAll {
    int mode, layer; bool dry;
    unsigned char* ws; float* out; const float* xp; const float* xs; const float* lng_next;
    bf16_t* hs; bf16_t* oth;
    DI void operator()(const acc_t& acc, const Unit& u, int wr, int wc, int fr_in, int fq_in) const {
        if (dry) return;
        int fr = fr_in, fq = fq_in; asm volatile("" : "+v"(fr), "+v"(fq));
        const int pn = u.pn, br = u.br;
        const int row0 = u.pm * 256 + wr * 64 + fr, cin = wc * 32 + 8 * fq;
        const int bidx = bidx_of_row(u.pm * 256);
        if (mode == 0) {
            const float* rowsq = (const float*)(ws + OFF_ROWSQ) + (size_t)layer * MTOT;
            const float* sw = (const float*)(ws + OFF_SW1) + ((size_t)layer * 9 + bidx) * N1 + pn * 256 + cin;
            f32x4 sv[2][2];
#pragma unroll
            for (int bj = 0; bj < 2; ++bj)
#pragma unroll
                for (int n = 0; n < 2; ++n) sv[bj][n] = *(const f32x4*)(sw + bj * 128 + 4 * n);
            size_t doff; int tb, ldd; bool act;
            if (pn < 6) { doff = OFF_QKV; tb = pn; ldd = 1536; act = false; }
            else if (pn < 8) { doff = OFF_ZA; tb = pn - 6; ldd = 512; act = true; }
            else if (pn < 12) { doff = OFF_UBZ; tb = 0; ldd = 512; act = false; }
            else if (pn < 14) { doff = (layer & 1) ? OFF_X : OFF_Y; tb = pn - 12; ldd = 512; act = false; }
            else if (pn < 16) { doff = OFF_XC; tb = pn - 14; ldd = 512; act = false; }
            else { doff = OFF_ZC; tb = pn - 16; ldd = 512; act = true; }
            bf16_t* dst = (bf16_t*)(ws + doff) + tb * 256 + cin;
            bf16_t* HALO = (bf16_t*)(ws + OFF_HALO) + pn * 256 + cin;
#pragma unroll
            for (int ai = 0; ai < 2; ++ai) {
                float rq[4];
#pragma unroll
                for (int m = 0; m < 4; ++m) rq[m] = rowsq[row0 + ai * 128 + m * 16];
#pragma unroll
                for (int m = 0; m < 4; ++m) {
                    const int row = row0 + ai * 128 + m * 16;
                    const float rinv = rsqrtf(rq[m] * (1.0f / DM) + EPS);
                    if (pn >= 8 && pn < 12) {
                        f32x4 o[2];
#pragma unroll
                        for (int n = 0; n < 2; ++n) {
                            const f32x4 uu = acc[ai][0][m][n] * rinv + sv[0][n], zz = acc[ai][1][m][n] * rinv + sv[1][n];
#pragma unroll
                            for (int j = 0; j < 4; ++j) o[n][j] = uu[j] * silu(zz[j]);
                        }
                        *(u32x4*)(dst + (size_t)row * 512 + (pn - 8) * 128) = pk8(o[0], o[1]);
                    } else if (pn == 18) {
                        if (wc == 0 && fq < 2) {
#pragma unroll
                            for (int n = 0; n < 2; ++n) *(f32x4*)((float*)(ws + OFF_BD) + (size_t)row * 16 + 8 * fq + 4 * n) = acc[ai][0][m][n] * rinv + sv[0][n];
                        }
                    } else {
#pragma unroll
                        for (int bj = 0; bj < 2; ++bj) {
                            f32x4 a = acc[ai][bj][m][0] * rinv + sv[bj][0], b = acc[ai][bj][m][1] * rinv + sv[bj][1];
                            if (act) {
#pragma unroll
                                for (int j = 0; j < 4; ++j) { a[j] = silu(a[j]); b[j] = silu(b[j]); }
                            }
                            const u32x4 w = pk8(a, b);
                            *(u32x4*)(dst + (size_t)row * ldd + bj * 128) = w;
                            if (pn < 6) {
                                if ((row & 63) == 0) *(u32x4*)(HALO + ((size_t)(row >> 6) * 2 + 0) * 1536 + bj * 128) = w;
                                if ((row & 63) == 63) *(u32x4*)(HALO + ((size_t)(row >> 6) * 2 + 1) * 1536 + bj * 128) = w;
                            }
                        }
                    }
                }
                asm volatile("" ::: "memory");
            }
        } else if (mode == 1) {
            const float* rowsq = (const float*)(ws + OFF_ROWSQ) + (size_t)layer * MTOT;
            const float* sw = (const float*)(ws + OFF_SWG) + ((size_t)layer * 9 + bidx) * NGATE + pn * 256 + cin;
            bf16_t* GT = (bf16_t*)(ws + OFF_G) + pn * 256 + cin;
            f32x4 sv[2][2];
#pragma unroll
            for (int bj = 0; bj < 2; ++bj)
#pragma unroll
                for (int n = 0; n < 2; ++n) sv[bj][n] = *(const f32x4*)(sw + bj * 128 + 4 * n);
#pragma unroll
            for (int ai = 0; ai < 2; ++ai) {
                float rq[4];
#pragma unroll
                for (int m = 0; m < 4; ++m) rq[m] = rowsq[row0 + ai * 128 + m * 16];
#pragma unroll
                for (int m = 0; m < 4; ++m) {
                    const int row = row0 + ai * 128 + m * 16;
                    const float rinv = rsqrtf(rq[m] * (1.0f / DM) + EPS);
#pragma unroll
                    for (int bj = 0; bj < 2; ++bj) {
                        f32x4 a = acc[ai][bj][m][0] * rinv + sv[bj][0], b = acc[ai][bj][m][1] * rinv + sv[bj][1];
#pragma unroll
                        for (int j = 0; j < 4; ++j) { a[j] = sigm(a[j]); b[j] = sigm(b[j]); }
                        *(u32x4*)(GT + (size_t)row * NGATE + bj * 128) = pk8(a, b);
                    }
                }
                asm volatile("" ::: "memory");
            }
        } else if (mode == 2) {
            const bf16_t* GT = (const bf16_t*)(ws + OFF_G) + br * 1024 + pn * 256 + cin;
            bf16_t* MG = hs + pn * 256 + cin;
#pragma unroll
            for (int hm = 0; hm < 4; ++hm) {
                const int ai = hm >> 1, mb = (hm & 1) * 2;
                u32x4 gc[2][2], pv[2][2];
#pragma unroll
                for (int mm = 0; mm < 2; ++mm)
#pragma unroll
                    for (int bj = 0; bj < 2; ++bj) gc[mm][bj] = *(const u32x4*)(GT + (size_t)(row0 + ai * 128 + (mb + mm) * 16) * NGATE + bj * 128);
                if (br > 0) {
                    bf16_t* p0 = MG + (size_t)(row0 + ai * 128 + mb * 16) * 1024;
                    asm volatile("global_load_dwordx4 %0, %4, off sc1\n\tglobal_load_dwordx4 %1, %4, off offset:256 sc1\n\t"
                                 "global_load_dwordx4 %2, %5, off sc1\n\tglobal_load_dwordx4 %3, %5, off offset:256 sc1\n\ts_waitcnt vmcnt(0)"
                                 : "=&v"(pv[0][0]), "=&v"(pv[0][1]), "=&v"(pv[1][0]), "=&v"(pv[1][1])
                                 : "v"(p0), "v"(p0 + 16 * 1024) : "memory");
                }
#pragma unroll
                for (int mm = 0; mm < 2; ++mm)
#pragma unroll
                    for (int bj = 0; bj < 2; ++bj) {
                        const u32x4 g = gc[mm][bj];
                        f32x4 a = acc[ai][bj][mb + mm][0] * (f32x4){bflo(g.x), bfhi(g.x), bflo(g.y), bfhi(g.y)};
                        f32x4 b = acc[ai][bj][mb + mm][1] * (f32x4){bflo(g.z), bfhi(g.z), bflo(g.w), bfhi(g.w)};
                        if (br > 0) {
                            const u32x4 p = pv[mm][bj];
                            a = a + (f32x4){bflo(p.x), bfhi(p.x), bflo(p.y), bfhi(p.y)};
                            b = b + (f32x4){bflo(p.z), bfhi(p.z), bflo(p.w), bfhi(p.w)};
                        }
                        *(u32x4*)(MG + (size_t)(row0 + ai * 128 + (mb + mm) * 16) * 1024 + bj * 128) = pk8(a, b);
                    }
                asm volatile("" ::: "memory");
            }
        } else {
            const float* hold = (layer == 0) ? (u.pm < 16 ? xp : xs - (size_t)MCTX * DM) : out;
            const float* gate = (const float*)(ws + OFF_MOD) + ((size_t)layer * 9 + bidx) * 3072 + 2048 + pn * 256 + cin;
            const float* gsc = (const float*)(ws + OFF_MOD) + ((size_t)(layer + 1 < NLAYER ? layer + 1 : layer) * 9 + bidx) * 3072 + 1024 + pn * 256 + cin;
            const float* lgn = lng_next + pn * 256 + cin;
            float* rsq = (float*)(ws + OFF_ROWSQ) + (size_t)(layer + 1) * MTOT;
            f32x4 gv[2][2], gs[2][2];
#pragma unroll
            for (int bj = 0; bj < 2; ++bj)
#pragma unroll
                for (int n = 0; n < 2; ++n) {
                    gv[bj][n] = *(const f32x4*)(gate + bj * 128 + 4 * n);
                    if (layer < 3) { const f32x4 lg = *(const f32x4*)(lgn + bj * 128 + 4 * n); const f32x4 sc = *(const f32x4*)(gsc + bj * 128 + 4 * n); gs[bj][n] = lg * (sc + 1.0f); }
                    else gs[bj][n] = (f32x4){0.f, 0.f, 0.f, 0.f};
                }
#pragma unroll
            for (int ai = 0; ai < 2; ++ai)
#pragma unroll
                for (int m = 0; m < 4; ++m) {
                    const int row = row0 + ai * 128 + m * 16;
                    float ss = 0.f;
#pragma unroll
                    for (int bj = 0; bj < 2; ++bj) {
                        const size_t off = (size_t)row * DM + pn * 256 + cin + bj * 128;
                        const f32x4 h0 = *(const f32x4*)(hold + off), h1 = *(const f32x4*)(hold + off + 4);
                        const f32x4 hn0 = h0 + gv[bj][0] * acc[ai][bj][m][0], hn1 = h1 + gv[bj][1] * acc[ai][bj][m][1];
                        *(f32x4*)(out + off) = hn0; *(f32x4*)(out + off + 4) = hn1;
                        ss += (hn0[0] * hn0[0] + hn0[1] * hn0[1]) + (hn0[2] * hn0[2] + hn0[3] * hn0[3]) + (hn1[0] * hn1[0] + hn1[1] * hn1[1]) + (hn1[2] * hn1[2] + hn1[3] * hn1[3]);
                        if (layer < 3) *(u32x4*)(oth + off) = pk8(hn0 * gs[bj][0], hn1 * gs[bj][1]);
                    }
                    ss += __shfl_xor(ss, 16); ss += __shfl_xor(ss, 32);
                    if (fq == 0) atomicAdd(rsq + row, ss);
                    if (m == 3) asm volatile("" ::: "memory");
                }
        }
    }
};

DI int colmap1(int n) {
    const int t = n >> 8, o = n & 255;
    if (t < 6) return n;
    if (t < 8) return 1552 + (n - 1536);
    if (t < 12) { const int i = t - 8; return o < 128 ? 2064 + 128 * i + o : 3088 + 128 * i + (o - 128); }
    if (t < 14) return 2576 + (n - 3072);
    if (t < 16) return 3600 + (n - 3584);
    if (t < 18) return 4112 + (n - 4096);
    return o < 16 ? 1536 + o : -1;
}
DI void transpose_item(const float* W, int Nsrc, int K, bf16_t* WT, int nblk, int mapkind, LAS float* scr, int item, int lane) {
    const int kb = item / nblk, nb = item % nblk, k0 = 64 * kb, n0 = 32 * nb;
    const int nn = n0 + (lane & 31);
    const int e = mapkind == 0 ? nn : (mapkind == 1 ? colmap1(nn) : 4624 + nn);
#pragma unroll 8
    for (int i = 0; i < 32; ++i) { const int kk = 2 * i + (lane >> 5); scr[kk * 33 + (lane & 31)] = e >= 0 ? W[(size_t)(k0 + kk) * Nsrc + e] : 0.f; }
    asm volatile("s_waitcnt lgkmcnt(0)" ::: "memory");
    const int c = lane & 7;
#pragma unroll
    for (int j = 0; j < 4; ++j) { const int n = (lane >> 3) + 8 * j; const LAS float* s = scr + (8 * c) * 33 + n;
        u32x4 o; o.x = pk2(s[0 * 33], s[1 * 33]); o.y = pk2(s[2 * 33], s[3 * 33]); o.z = pk2(s[4 * 33], s[5 * 33]); o.w = pk2(s[6 * 33], s[7 * 33]);
        *(u32x4*)(WT + (size_t)(n0 + n) * K + k0 + 8 * c) = o; }
    asm volatile("s_waitcnt lgkmcnt(0)" ::: "memory");
}
DI void transpose_seg(const float* W, int Nsrc, int K, bf16_t* WT, int Ndst, int mapkind, LAS float* scr, int gw, int NGW, int lane) {
    const int nblk = Ndst / 32, nitems = (K / 64) * nblk;
    for (int it = gw; it < nitems; it += NGW) transpose_item(W, Nsrc, K, WT, nblk, mapkind, scr, it, lane);
}

DI void gemv9_item(const LAS float* in_s, LAS float* red, const float* W, int ldw, int mapkind, const float* bias, float* out, int ldo, int n0) {
    const int t = tid_opaque(), col = t & 63, part = t >> 6;
    const int nn = n0 + col;
    const int e = mapkind == 0 ? nn : (mapkind == 1 ? colmap1(nn) : 4624 + nn);
    float a[9];
#pragma unroll
    for (int j = 0; j < 9; ++j) a[j] = 0.f;
    if (e >= 0) {
        const float* wp = W + (size_t)(part * 128) * ldw + e;
        for (int d0 = 0; d0 < 128; d0 += 16) {
            float wv[16];
#pragma unroll
            for (int e = 0; e < 16; ++e) wv[e] = wp[(size_t)(d0 + e) * ldw];
#pragma unroll
            for (int q4 = 0; q4 < 4; ++q4) {
#pragma unroll
                for (int j = 0; j < 9; ++j) { const f32x4 x = *(const LAS f32x4*)(in_s + j * 1024 + part * 128 + d0 + 4 * q4);
                    a[j] += (x[0] * wv[4 * q4] + x[1] * wv[4 * q4 + 1]) + (x[2] * wv[4 * q4 + 2] + x[3] * wv[4 * q4 + 3]); }
            }
        }
    }
#pragma unroll
    for (int j = 0; j < 9; ++j) red[(part * 9 + j) * 64 + col] = a[j];
    __syncthreads();
    for (int o = t; o < 9 * 64; o += NTHREADS) {
        const int j = o >> 6, c = o & 63;
        const int n2 = n0 + c;
        const int e2 = mapkind == 0 ? n2 : (mapkind == 1 ? colmap1(n2) : 4624 + n2);
        float sm = 0.f;
#pragma unroll
        for (int p = 0; p < 8; ++p) sm += red[(p * 9 + j) * 64 + c];
        if (e2 >= 0 && bias) sm += bias[e2];
        out[(size_t)j * ldo + n2] = (e2 >= 0) ? sm : 0.f;
    }
    __syncthreads();
}

DI void d1_item(const bool dry, LAS unsigned char* lds, int item, bf16_t* QKV, const bf16_t* HALO, const float* BD, const float* convw, float* GB, bf16_t* TQ, const float* alog, const float* dtb) {
    const int t = tid_opaque(), lane = t & 63, wid = __builtin_amdgcn_readfirstlane(t >> 6);
    const int cg_ = item >> 2, h = item & 3;
    const int rowbase = cg_ * 64;
    int cin_seq, nch;
    if (rowbase < MCTX) { cin_seq = cg_ & 3; nch = 4; } else { cin_seq = (cg_ - 64) & 63; nch = 64; }
    LAS bf16_t* Qs = (LAS bf16_t*)lds;
    LAS bf16_t* Ks = Qs + 64 * 136;
    LAS float* KK = (LAS float*)(lds + 2 * 64 * 136 * 2);
    LAS float* As = KK + 64 * 65;
    LAS float* graw = As + 2 * 64 * 68;
    LAS float* braw = graw + 128;
    LAS float* gam = braw + 128;
    LAS float* bet = gam + 128;
    {
        const int c8 = (t & 15) * 8, rg = t >> 4;
#pragma unroll 1
        for (int ten = 0; ten < 3; ++ten) {
            float res[2][8];
            const int col = ten * 512 + h * 128 + c8;
            {
                u32x4 x[4];
#pragma unroll
                for (int rr = 0; rr < 4; ++rr) {
                    const int li = 2 * rg - 1 + rr;
                    if (li < 0) x[rr] = (cin_seq == 0) ? (u32x4){0u, 0u, 0u, 0u} : *(const u32x4*)(HALO + ((size_t)(cg_ - 1) * 2 + 1) * 1536 + col);
                    else if (li > 63) x[rr] = (cin_seq == nch - 1) ? (u32x4){0u, 0u, 0u, 0u} : *(const u32x4*)(HALO + ((size_t)(cg_ + 1) * 2 + 0) * 1536 + col);
                    else x[rr] = *(const u32x4*)(QKV + (size_t)(rowbase + li) * 1536 + col);
                }
                float w[3][8];
#pragma unroll
                for (int j = 0; j < 3; ++j) { const f32x4 a = *(const f32x4*)(convw + j * 1536 + col), b = *(const f32x4*)(convw + j * 1536 + col + 4);
                    w[j][0] = a[0]; w[j][1] = a[1]; w[j][2] = a[2]; w[j][3] = a[3]; w[j][4] = b[0]; w[j][5] = b[1]; w[j][6] = b[2]; w[j][7] = b[3]; }
                float xf[4][8];
#pragma unroll
                for (int rr = 0; rr < 4; ++rr) { xf[rr][0] = bflo(x[rr].x); xf[rr][1] = bfhi(x[rr].x); xf[rr][2] = bflo(x[rr].y); xf[rr][3] = bfhi(x[rr].y);
                    xf[rr][4] = bflo(x[rr].z); xf[rr][5] = bfhi(x[rr].z); xf[rr][6] = bflo(x[rr].w); xf[rr][7] = bfhi(x[rr].w); }
#pragma unroll
                for (int o = 0; o < 2; ++o)
#pragma unroll
                    for (int e = 0; e < 8; ++e) res[o][e] = silu(w[0][e] * xf[o][e] + w[1][e] * xf[o + 1][e] + w[2][e] * xf[o + 2][e]);
            }
            if (ten < 2) {
#pragma unroll
                for (int o = 0; o < 2; ++o) {
                    float s = 0.f;
#pragma unroll
                    for (int e = 0; e < 8; ++e) s += res[o][e] * res[o][e];
                    s += __shfl_xor(s, 1); s += __shfl_xor(s, 2); s += __shfl_xor(s, 4); s += __shfl_xor(s, 8);
                    const float sc = rsqrtf(s + EPS) * (ten == 0 ? 0.08838834764831845f : 1.0f);
#pragma unroll
                    for (int e = 0; e < 8; ++e) res[o][e] *= sc;
                }
            }
            __syncthreads();
#pragma unroll
            for (int o = 0; o < 2; ++o) {
                u32x4 w; w.x = pk2(res[o][0], res[o][1]); w.y = pk2(res[o][2], res[o][3]); w.z = pk2(res[o][4], res[o][5]); w.w = pk2(res[o][6], res[o][7]);
                const int li = 2 * rg + o;
                if (!dry) *(u32x4*)(QKV + (size_t)(rowbase + li) * 1536 + col) = w;
                if (ten == 0) *(LAS u32x4*)(Qs + li * 136 + c8) = w;
                if (ten == 1) *(LAS u32x4*)(Ks + li * 136 + c8) = w;
            }
        }
        if (t < 128) { const int d = t >> 6, i = t & 63; graw[t] = -__expf(alog[d * 4 + h]) * softplus(BD[(size_t)(rowbase + i) * 16 + 8 + d * 4 + h] + dtb[d * 4 + h]); braw[t] = sigm(BD[(size_t)(rowbase + i) * 16 + d * 4 + h]); }
    }
    __syncthreads();
#pragma unroll
    for (int tt = 0; tt < 2; ++tt) {
        const int tile = wid * 2 + tt, mi = tile >> 2, ni = tile & 3;
        f32x4 acc = (f32x4){0.f, 0.f, 0.f, 0.f};
        acc = mma_tile(acc, Ks + mi * 16 * 136, 136, Ks + ni * 16 * 136, 136, 128, lane);
#pragma unroll
        for (int j = 0; j < 4; ++j) KK[(mi * 16 + (lane >> 4) * 4 + j) * 65 + ni * 16 + (lane & 15)] = acc[j];
    }
    if (t < 128) {
        const int d = t >> 6, ip = t & 63, oi = d ? 63 - ip : ip;
        float g = graw[d * 64 + oi];
#pragma unroll
        for (int o = 1; o < 64; o <<= 1) { const float y = __shfl_up(g, o); if (ip >= o) g += y; }
        const float b = braw[d * 64 + oi];
        gam[t] = g; bet[t] = b;
        float* gb = GB + ((size_t)(cg_ * 4 + h) * 2 + d) * 128;
        if (!dry) { gb[ip] = g; gb[64 + ip] = b; }
    }
    __syncthreads();
    for (int e = t; e < 2 * 4096; e += NTHREADS) {
        const int d = e >> 12, ip = (e >> 6) & 63, jp = e & 63;
        float v = 0.f;
        if (ip > jp) { const int oi = d ? 63 - ip : ip, oj = d ? 63 - jp : jp; v = bet[d * 64 + ip] * KK[oi * 65 + oj] * __expf(gam[d * 64 + ip] - gam[d * 64 + jp]); }
        As[(d * 64 + ip) * 68 + jp] = v;
    }
    __syncthreads();
    if (t < 128) {
        const int d = t >> 6, c = t & 63;
        const LAS float* Ad = As + d * 64 * 68;
        float x[64];
#pragma unroll
        for (int i = 0; i < 64; ++i) {
            float s = (i == c) ? 1.f : 0.f;
#pragma unroll
            for (int j4 = 0; j4 < (i + 3) / 4; ++j4) {
                const f32x4 a = *(const LAS f32x4*)(Ad + i * 68 + j4 * 4);
#pragma unroll
                for (int jj = 0; jj < 4; ++jj) { if (j4 * 4 + jj < i) s -= a[jj] * x[j4 * 4 + jj]; }
            }
            x[i] = s;
        }
        bf16_t* tq = TQ + ((size_t)(cg_ * 4 + h) * 2 + d) * 4096;
#pragma unroll
        for (int i = 0; i < 64; ++i) if (!dry) tq[i * 64 + c] = (bf16_t)f2bf(x[i]);
    }
    __syncthreads();
}

DI void sgu_item(const bool dry, LAS unsigned char* lds, int item, const bf16_t* VB, bf16_t* UBZ, const float* gnorm, const float* wsp, const float* bsp) {
    const int t = tid_opaque(), lane = t & 63, wid = __builtin_amdgcn_readfirstlane(t >> 6);
    const int cb = item >> 2, g = item & 3, r0 = cb * 128;
    LAS bf16_t* Ws = (LAS bf16_t*)lds;
    LAS bf16_t* VT = Ws + 128 * 136;
    LAS float* rinv = (LAS float*)(lds + 2 * 128 * 136 * 2);
    {
        const int q = t >> 2, sub = t & 3;
        const bf16_t* vp = VB + (size_t)(r0 + q) * 512 + sub * 128;
        float s = 0.f;
#pragma unroll
        for (int i = 0; i < 16; ++i) { const u32x4 x = *(const u32x4*)(vp + i * 8);
            const float a0 = bflo(x.x), a1 = bfhi(x.x), a2 = bflo(x.y), a3 = bfhi(x.y), a4 = bflo(x.z), a5 = bfhi(x.z), a6 = bflo(x.w), a7 = bfhi(x.w);
            s += (a0 * a0 + a1 * a1) + (a2 * a2 + a3 * a3) + (a4 * a4 + a5 * a5) + (a6 * a6 + a7 * a7); }
        s += __shfl_xor(s, 1); s += __shfl_xor(s, 2);
        if (sub == 0) rinv[q] = rsqrtf(s * (1.0f / 512.0f) + EPS);
        for (int e = t; e < 128 * 32; e += NTHREADS) { const int p = e >> 5, c4 = (e & 31) * 4; const f32x4 w = *(const f32x4*)(wsp + (size_t)g * 16384 + p * 128 + c4);
            u32x2 o; o.x = pk2(w[0], w[1]); o.y = pk2(w[2], w[3]); *(LAS u32x2*)(Ws + p * 136 + c4) = o; }
    }
    __syncthreads();
    {
        const int q = t >> 2, sub = t & 3;
        const float ri = rinv[q];
#pragma unroll
        for (int i = 0; i < 4; ++i) {
            const int c0 = sub * 32 + i * 8;
            const u32x4 x = *(const u32x4*)(VB + (size_t)(r0 + q) * 512 + g * 128 + c0);
            const f32x4 g0 = *(const f32x4*)(gnorm + g * 128 + c0), g1 = *(const f32x4*)(gnorm + g * 128 + c0 + 4);
            const float v[8] = {bflo(x.x) * ri * g0[0], bfhi(x.x) * ri * g0[1], bflo(x.y) * ri * g0[2], bfhi(x.y) * ri * g0[3], bflo(x.z) * ri * g1[0], bfhi(x.z) * ri * g1[1], bflo(x.w) * ri * g1[2], bfhi(x.w) * ri * g1[3]};
#pragma unroll
            for (int e = 0; e < 8; ++e) VT[(c0 + e) * 136 + q] = (bf16_t)f2bf(v[e]);
        }
    }
    __syncthreads();
#pragma unroll 1
    for (int ni = 0; ni < 8; ++ni) {
        f32x4 acc = (f32x4){0.f, 0.f, 0.f, 0.f};
        acc = mma_tile(acc, Ws + wid * 16 * 136, 136, VT + ni * 16 * 136, 136, 128, lane);
        const int c = g * 128 + ni * 16 + (lane & 15);
#pragma unroll
        for (int j = 0; j < 4; ++j) {
            const int p = wid * 16 + (lane >> 4) * 4 + j;
            bf16_t* up = UBZ + (size_t)(r0 + p) * 512 + c;
            const float o = bf2f(*up) * (acc[j] + bsp[g * 128 + p]);
            if (!dry) *up = (bf16_t)f2bf(o);
        }
    }
    __syncthreads();
}

DI void f1_load_tables(LAS unsigned char* lds, const bf16_t* tab) {
    LAS bf16_t* Fs = (LAS bf16_t*)lds;
    LAS bf16_t* M2s = Fs + 256 * 136;
    const bf16_t* FCH = tab + TAB_FCH / 2; const bf16_t* M2 = tab + TAB_M2 / 2;
    const int t0_ = tid_opaque();
    for (int e = t0_; e < 256 * 16; e += NTHREADS) { const int r = e >> 4, c8 = (e & 15) * 8; *(LAS u32x4*)(Fs + r * 136 + c8) = *(const u32x4*)(FCH + r * 128 + c8); }
    for (int e = t0_; e < 128 * 16; e += NTHREADS) { const int r = e >> 4, c8 = (e & 15) * 8; *(LAS u32x4*)(M2s + r * 136 + c8) = *(const u32x4*)(M2 + r * 128 + c8); }
    __syncthreads();
}
DI void f1_item(const bool dry, LAS unsigned char* lds, int item, bf16_t* XC, bf16_t* IM) {
    const int t = tid_opaque(), lane = t & 63, wid = __builtin_amdgcn_readfirstlane(t >> 6), r = lane & 15, q = lane >> 4;
    LAS bf16_t* Fs = (LAS bf16_t*)lds;
    LAS bf16_t* M2s = Fs + 256 * 136;
    LAS bf16_t* Z1T = M2s + 128 * 136;
    const bool latent = item < 2048;
    int row0, g;
    if (latent) { const int s = item >> 8, rr = (item >> 2) & 63; g = item & 3; row0 = MCTX + s * 4096 + rr * 64; }
    else { const int it = item - 2048; const int s = it >> 4, tb = (it >> 2) & 3; g = it & 3; row0 = s * 256 + tb * 64; }
    bf16x8 xf[4][4];
#pragma unroll
    for (int mt = 0; mt < 4; ++mt)
#pragma unroll
        for (int ks = 0; ks < 4; ++ks) xf[mt][ks] = *(const bf16x8*)(XC + (size_t)(row0 + mt * 16 + r) * 512 + g * 128 + ks * 32 + q * 8);
    __syncthreads();
    if (latent) {
#pragma unroll
        for (int nn = 0; nn < 2; ++nn) {
            const int nt_ = wid * 2 + nn;
            bf16x8 bfr[4];
#pragma unroll
            for (int ks = 0; ks < 4; ++ks) bfr[ks] = *(const LAS bf16x8*)(Fs + (nt_ * 16 + r) * 136 + ks * 32 + q * 8);
#pragma unroll
            for (int mt = 0; mt < 4; ++mt) {
                f32x4 acc = (f32x4){0.f, 0.f, 0.f, 0.f};
#pragma unroll
                for (int ks = 0; ks < 4; ++ks) acc = mfma16(xf[mt][ks], bfr[ks], acc);
                u32x2 w; w.x = pk2(acc[0], acc[1]); w.y = pk2(acc[2], acc[3]);
                *(LAS u32x2*)(Z1T + (nt_ * 16 + r) * 72 + mt * 16 + q * 4) = w;
            }
        }
        __syncthreads();
        bf16x8 af[4];
#pragma unroll
        for (int ks = 0; ks < 4; ++ks) { const int nrow = (ks < 2 ? 0 : 128) + wid * 16 + r; af[ks] = *(const LAS bf16x8*)(Z1T + nrow * 72 + (ks & 1) * 32 + q * 8); }
#pragma unroll 1
        for (int ct = 0; ct < 8; ++ct) {
            f32x4 acc = (f32x4){0.f, 0.f, 0.f, 0.f};
#pragma unroll
            for (int ks = 0; ks < 4; ++ks) { const bf16x8 b = *(const LAS bf16x8*)(M2s + (ct * 16 + r) * 136 + ks * 32 + q * 8); acc = mfma16(af[ks], b, acc); }
            const int c2p = ct * 16 + r;
            bf16_t* dst = (c2p < 64) ? XC : IM;
            u32x2 w; w.x = pk2(acc[0], acc[1]); w.y = pk2(acc[2], acc[3]);
            if (!dry) *(u32x2*)(dst + (size_t)(row0 + (c2p & 63)) * 512 + g * 128 + wid * 16 + q * 4) = w;
        }
    } else {
#pragma unroll
        for (int nn = 0; nn < 2; ++nn) {
            const int nt_ = wid * 2 + nn;
            bf16x8 afr[4];
#pragma unroll
            for (int ks = 0; ks < 4; ++ks) afr[ks] = *(const LAS bf16x8*)(Fs + (nt_ * 16 + r) * 136 + ks * 32 + q * 8);
#pragma unroll
            for (int mt = 0; mt < 4; ++mt) {
                f32x4 acc = (f32x4){0.f, 0.f, 0.f, 0.f};
#pragma unroll
                for (int ks = 0; ks < 4; ++ks) acc = mfma16(afr[ks], xf[mt][ks], acc);
                const int n = nt_ * 16 + q * 4;
                bf16_t* dst = (n < 128) ? XC : IM;
                u32x2 w; w.x = pk2(acc[0], acc[1]); w.y = pk2(acc[2], acc[3]);
                if (!dry) *(u32x2*)(dst + (size_t)(row0 + mt * 16 + r) * 512 + g * 128 + (n & 127)) = w;
            }
        }
    }
    __syncthreads();
}

DI void f3_latent_item(const bool dry, LAS unsigned char* lds, int item, bf16_t* XC, const bf16_t* IM, const bf16_t* ZC) {
    const int t = tid_opaque(), lane = t & 63, wid = __builtin_amdgcn_readfirstlane(t >> 6), r = lane & 15, q = lane >> 4;
    LAS bf16_t* CSs = (LAS bf16_t*)lds;
    LAS bf16_t* ZT = CSs + 64 * 136;
    const int s = item >> 8, g = (item >> 6) & 3, c2 = item & 63;
    const int tok0 = MCTX + s * 4096 + c2;
#pragma unroll
    for (int i = 0; i < 4; ++i) {
        const int e = t + i * NTHREADS, kk = e >> 4, c8 = (e & 15) * 8;
        const bf16_t* src = (kk < 64 ? XC : IM) + (size_t)(tok0 + (kk & 63) * 64) * 512 + g * 128 + c8;
        const u32x4 x = *(const u32x4*)src;
        const unsigned v[4] = {x.x, x.y, x.z, x.w};
#pragma unroll
        for (int p = 0; p < 4; ++p) { ZT[(c8 + 2 * p) * 136 + kk] = (bf16_t)(v[p] & 0xffffu); ZT[(c8 + 2 * p + 1) * 136 + kk] = (bf16_t)(v[p] >> 16); }
    }
    __syncthreads();
    const float nrm = 0.0013810679320049757f;
#pragma unroll 1
    for (int rt = 0; rt < 4; ++rt) {
        f32x4 acc = (f32x4){0.f, 0.f, 0.f, 0.f};
        acc = mma_tile(acc, ZT + wid * 16 * 136, 136, CSs + rt * 16 * 136, 136, 128, lane);
        const size_t off = (size_t)(tok0 + (rt * 16 + r) * 64) * 512 + g * 128 + wid * 16 + q * 4;
        const u32x2 z = *(const u32x2*)(ZC + off);
        u32x2 w; w.x = pk2(acc[0] * nrm * bflo(z.x), acc[1] * nrm * bfhi(z.x)); w.y = pk2(acc[2] * nrm * bflo(z.y), acc[3] * nrm * bfhi(z.y));
        if (!dry) *(u32x2*)(XC + off) = w;
    }
    __syncthreads();
}
DI void f3_context_item(const bool dry, LAS unsigned char* lds, int item, bf16_t* XC, const bf16_t* IM, const bf16_t* ZC, const bf16_t* CS256, bf16_t* OUT) {
    const int t = tid_opaque(), lane = t & 63, wid = __builtin_amdgcn_readfirstlane(t >> 6), r = lane & 15, q = lane >> 4;
    LAS bf16_t* ZT = (LAS bf16_t*)lds;
    const int s = item >> 4, g = (item >> 2) & 3, qt = item & 3, tok0 = s * 256;
    const int tt = qt * 4 + (wid >> 1), m0 = (wid & 1) * 4;
    bf16x8 bfr[16];
#pragma unroll
    for (int ks = 0; ks < 16; ++ks) bfr[ks] = *(const bf16x8*)(CS256 + (size_t)(tt * 16 + r) * 512 + ks * 32 + q * 8);
    for (int e = t; e < 512 * 16; e += NTHREADS) {
        const int kk = e >> 4, c8 = (e & 15) * 8;
        const bf16_t* src = (kk < 256 ? XC : IM) + (size_t)(tok0 + (kk & 255)) * 512 + g * 128 + c8;
        const u32x4 x = *(const u32x4*)src;
        const unsigned v[4] = {x.x, x.y, x.z, x.w};
#pragma unroll
        for (int p = 0; p < 4; ++p) { ZT[(c8 + 2 * p) * 520 + kk] = (bf16_t)(v[p] & 0xffffu); ZT[(c8 + 2 * p + 1) * 520 + kk] = (bf16_t)(v[p] >> 16); }
    }
    __syncthreads();
    const float nrm = 0.005524271728019903f;
    f32x4 acc[4];
#pragma unroll
    for (int m = 0; m < 4; ++m) acc[m] = (f32x4){0.f, 0.f, 0.f, 0.f};
#pragma unroll
    for (int ks = 0; ks < 16; ++ks) {
#pragma unroll
        for (int m = 0; m < 4; ++m) { const bf16x8 a = *(const LAS bf16x8*)(ZT + ((m0 + m) * 16 + r) * 520 + ks * 32 + q * 8); acc[m] = mfma16(a, bfr[ks], acc[m]); }
    }
#pragma unroll
    for (int m = 0; m < 4; ++m) {
        const size_t off = (size_t)(tok0 + tt * 16 + r) * 512 + g * 128 + (m0 + m) * 16 + q * 4;
        const u32x2 z = *(const u32x2*)(ZC + off);
        u32x2 w; w.x = pk2(acc[m][0] * nrm * bflo(z.x), acc[m][1] * nrm * bfhi(z.x)); w.y = pk2(acc[m][2] * nrm * bflo(z.y), acc[m][3] * nrm * bfhi(z.y));
        if (!dry) *(u32x2*)(OUT + off) = w;
    }
    __syncthreads();
}

#define LBAR do { asm volatile("s_waitcnt lgkmcnt(0)" ::: "memory"); __builtin_amdgcn_s_barrier(); asm volatile("" ::: "memory"); } while (0)
DI void chain_item(LAS unsigned char* lds, int item, int layer, const bf16_t* QKV, const bf16_t* TQ, const float* GB, bf16_t* OF, bf16_t* OB, const float* state_in, float* state_out) {
    const int t = tid_opaque(), lane = t & 63, wid = __builtin_amdgcn_readfirstlane(t >> 6), r = lane & 15, q = lane >> 4;
    LAS bf16_t* KS = (LAS bf16_t*)lds;
    LAS bf16_t* QS = KS + 64 * 136;
    LAS bf16_t* KT = QS + 64 * 136;
    LAS bf16_t* TS = KT + 128 * 72;
    LAS bf16_t* QKM = TS + 64 * 72;
    LAS bf16_t* ST = QKM + 64 * 72;
    LAS bf16_t* XT = ST + 2 * 32 * 136;
    LAS bf16_t* UT = XT + 32 * 72;
    LAS bf16_t* UDT = UT + 32 * 72;
    LAS float* VBs = (LAS float*)(UDT + 32 * 72);
    LAS float* gam = VBs + 64 * 36;
    LAS float* bet = gam + 64;
    int rs, nch, sidx; bool latent = item < 256;
    const int ii = latent ? item : item - 256;
    const int h = (ii >> 3) & 3, d = (ii >> 2) & 1, vs = ii & 3; sidx = ii >> 5;
    if (latent) { rs = MCTX + sidx * 4096; nch = 64; } else { rs = sidx * 256; nch = 4; }
    bf16_t* O = d ? OB : OF;
    f32x4 sacc[2];
#pragma unroll
    for (int ni = 0; ni < 2; ++ni) {
        if (latent) {
            const float* sp = state_in + ((((size_t)sidx * NLAYER + layer) * 2 + d) * 4 + h) * 16384;
#pragma unroll
            for (int j = 0; j < 4; ++j) sacc[ni][j] = sp[(size_t)(wid * 16 + q * 4 + j) * 128 + vs * 32 + ni * 16 + r];
        } else sacc[ni] = (f32x4){0.f, 0.f, 0.f, 0.f};
        u32x2 w; w.x = pk2(sacc[ni][0], sacc[ni][1]); w.y = pk2(sacc[ni][2], sacc[ni][3]);
        *(LAS u32x2*)(ST + (ni * 16 + r) * 136 + wid * 16 + q * 4) = w;
    }
    const int ki = t >> 3, kseg = (t & 7) * 16;
    const int vi = (t >> 2) & 63, vseg = (t & 3) * 8;
    u32x4 kreg[2], qreg[2], vreg, treg; float gv = 0.f, bv = 0.f, bvv = 0.f;
#define CH_PREFETCH(n) do { const int c_ = d ? nch - 1 - (n) : (n); const int cgl = (rs >> 6) + c_; \
        const size_t orow = (size_t)rs + c_ * 64 + (d ? 63 - ki : ki); \
        kreg[0] = *(const u32x4*)(QKV + orow * 1536 + 512 + h * 128 + kseg); kreg[1] = *(const u32x4*)(QKV + orow * 1536 + 512 + h * 128 + kseg + 8); \
        qreg[0] = *(const u32x4*)(QKV + orow * 1536 + h * 128 + kseg); qreg[1] = *(const u32x4*)(QKV + orow * 1536 + h * 128 + kseg + 8); \
        const size_t base_ = (size_t)(cgl * 4 + h) * 2 + d; \
        treg = *(const u32x4*)(TQ + base_ * 4096 + (size_t)ki * 64 + (t & 7) * 8); \
        if (t < 256) { const size_t vrow = (size_t)rs + c_ * 64 + (d ? 63 - vi : vi); vreg = *(const u32x4*)(QKV + vrow * 1536 + 1024 + h * 128 + vs * 32 + vseg); bvv = GB[base_ * 128 + 64 + vi]; } \
        if (t < 64) { gv = GB[base_ * 128 + t]; bv = GB[base_ * 128 + 64 + t]; } } while (0)
    CH_PREFETCH(0);
    for (int n = 0; n < nch; ++n) {
        const int cur = n & 1;
        LAS bf16_t* STc = ST + cur * 32 * 136; LAS bf16_t* STn = ST + (cur ^ 1) * 32 * 136;
        *(LAS u32x4*)(KS + ki * 136 + kseg) = kreg[0]; *(LAS u32x4*)(KS + ki * 136 + kseg + 8) = kreg[1];
        *(LAS u32x4*)(QS + ki * 136 + kseg) = qreg[0]; *(LAS u32x4*)(QS + ki * 136 + kseg + 8) = qreg[1];
        {
            const unsigned kv[8] = {kreg[0].x, kreg[0].y, kreg[0].z, kreg[0].w, kreg[1].x, kreg[1].y, kreg[1].z, kreg[1].w};
#pragma unroll
            for (int p = 0; p < 8; ++p) { KT[(kseg + 2 * p) * 72 + ki] = (bf16_t)(kv[p] & 0xffffu); KT[(kseg + 2 * p + 1) * 72 + ki] = (bf16_t)(kv[p] >> 16); }
        }
        {
            const int i = ki, j0 = (t & 7) * 8;
            unsigned tv[4] = {treg.x, treg.y, treg.z, treg.w};
#pragma unroll
            for (int p = 0; p < 4; ++p) {
                const int ja = j0 + 2 * p, jb = ja + 1;
                unsigned lo = tv[p] & 0xffffu, hi = tv[p] >> 16;
                if (ja >= i) lo = (ja == i) ? 0x3f80u : 0u;
                if (jb >= i) hi = (jb == i) ? 0x3f80u : 0u;
                tv[p] = lo | (hi << 16);
            }
            *(LAS u32x4*)(TS + i * 72 + j0) = (u32x4){tv[0], tv[1], tv[2], tv[3]};
        }
        if (t < 256) {
            const float vv[8] = {bflo(vreg.x), bfhi(vreg.x), bflo(vreg.y), bfhi(vreg.y), bflo(vreg.z), bfhi(vreg.z), bflo(vreg.w), bfhi(vreg.w)};
            *(LAS f32x4*)(VBs + vi * 36 + vseg) = (f32x4){vv[0] * bvv, vv[1] * bvv, vv[2] * bvv, vv[3] * bvv};
            *(LAS f32x4*)(VBs + vi * 36 + vseg + 4) = (f32x4){vv[4] * bvv, vv[5] * bvv, vv[6] * bvv, vv[7] * bvv};
        }
        if (t < 64) { gam[t] = gv; bet[t] = bv; }
        LBAR;
        if (n + 1 < nch) CH_PREFETCH(n + 1);
        const float glast = gam[63];
#pragma unroll
        for (int tt = 0; tt < 2; ++tt) {
            const int tile = wid * 2 + tt, mi = tile >> 2, ni = tile & 3;
            f32x4 acc = (f32x4){0.f, 0.f, 0.f, 0.f};
            if (ni <= mi) acc = mma_tile(acc, QS + mi * 16 * 136, 136, KS + ni * 16 * 136, 136, 128, lane);
            const int jj = ni * 16 + r; const float gj = gam[jj];
#pragma unroll
            for (int j = 0; j < 4; ++j) { const int i = mi * 16 + q * 4 + j; const float v = (i >= jj) ? acc[j] * __expf(gam[i] - gj) : 0.f; QKM[i * 72 + jj] = (bf16_t)f2bf(v); }
        }
        const int mi = wid >> 1, ni = wid & 1;
        {
            f32x4 acc = (f32x4){0.f, 0.f, 0.f, 0.f};
            acc = mma_tile(acc, KS + mi * 16 * 136, 136, STc + ni * 16 * 136, 136, 128, lane);
            float x[4];
#pragma unroll
            for (int j = 0; j < 4; ++j) { const int i = mi * 16 + q * 4 + j; x[j] = VBs[i * 36 + ni * 16 + r] - bet[i] * __expf(gam[i]) * acc[j]; }
            u32x2 w; w.x = pk2(x[0], x[1]); w.y = pk2(x[2], x[3]);
            *(LAS u32x2*)(XT + (ni * 16 + r) * 72 + mi * 16 + q * 4) = w;
        }
        LBAR;
        {
            f32x4 acc = (f32x4){0.f, 0.f, 0.f, 0.f};
            acc = mma_tile(acc, TS + mi * 16 * 72, 72, XT + ni * 16 * 72, 72, 64, lane);
            float ud[4];
#pragma unroll
            for (int j = 0; j < 4; ++j) { const int i = mi * 16 + q * 4 + j; ud[j] = acc[j] * __expf(glast - gam[i]); }
            u32x2 w; w.x = pk2(acc[0], acc[1]); w.y = pk2(acc[2], acc[3]);
            *(LAS u32x2*)(UT + (ni * 16 + r) * 72 + mi * 16 + q * 4) = w;
            u32x2 w2; w2.x = pk2(ud[0], ud[1]); w2.y = pk2(ud[2], ud[3]);
            *(LAS u32x2*)(UDT + (ni * 16 + r) * 72 + mi * 16 + q * 4) = w2;
        }
        LBAR;
        {
            f32x4 acc = (f32x4){0.f, 0.f, 0.f, 0.f};
            acc = mma_tile(acc, QS + mi * 16 * 136, 136, STc + ni * 16 * 136, 136, 128, lane);
#pragma unroll
            for (int j = 0; j < 4; ++j) acc[j] *= __expf(gam[mi * 16 + q * 4 + j]);
            acc = mma_tile(acc, QKM + mi * 16 * 72, 72, UT + ni * 16 * 72, 72, 64, lane);
            const int c_ = d ? nch - 1 - n : n;
#pragma unroll
            for (int j = 0; j < 4; ++j) { const int i = mi * 16 + q * 4 + j; const size_t orow = (size_t)rs + c_ * 64 + (d ? 63 - i : i);
                O[orow * 512 + h * 128 + vs * 32 + ni * 16 + r] = (bf16_t)f2bf(acc[j]); }
        }
        {
            const float gl = __expf(glast);
#pragma unroll
            for (int n2 = 0; n2 < 2; ++n2) {
                sacc[n2] = sacc[n2] * gl;
                sacc[n2] = mma_tile(sacc[n2], KT + wid * 16 * 72, 72, UDT + n2 * 16 * 72, 72, 64, lane);
                u32x2 w; w.x = pk2(sacc[n2][0], sacc[n2][1]); w.y = pk2(sacc[n2][2], sacc[n2][3]);
                *(LAS u32x2*)(STn + (n2 * 16 + r) * 136 + wid * 16 + q * 4) = w;
            }
        }
        LBAR;
    }
#undef CH_PREFETCH
    if (!latent) {
        float* sp = state_out + ((((size_t)sidx * NLAYER + layer) * 2 + d) * 4 + h) * 16384;
#pragma unroll
        for (int n2 = 0; n2 < 2; ++n2)
#pragma unroll
            for (int j = 0; j < 4; ++j) sp[(size_t)(wid * 16 + q * 4 + j) * 128 + vs * 32 + n2 * 16 + r] = sacc[n2][j];
    }
}

__global__ void __launch_bounds__(NTHREADS) mega_fwd(Params P) {
    extern __shared__ __attribute__((aligned(16))) unsigned char lds_raw[];
    LAS unsigned char* lds = (LAS unsigned char*)lds_raw;
    cg::grid_group grid = cg::this_grid();
    const int G = gridDim.x, bx = blockIdx.x, NGW = G * 8;
    const int xcc = (int)(__builtin_amdgcn_s_getreg((3 << 11) | 20) & 0xFu);
    int myrank = 0, cvirt = bx;
    bool fastbar = false;
#pragma unroll 1
    for (int step0 = -2 * DUP_P0; step0 < 27; ++step0) {
        const int step = step0 < 0 ? step0 + 2 : step0;
        const int kind = step < 2 ? step : (step == 26 ? 8 : 2 + (step - 2) % 6);
        const int l = step < 2 ? 0 : (step == 26 ? 3 : (step - 2) / 6);
        const int t = tid_opaque(), lane = t & 63, wid = __builtin_amdgcn_readfirstlane(t >> 6), gw = bx * 8 + wid;
        unsigned char* ws = P.ws;
        float* out = P.out;
        bf16_t* HS = (bf16_t*)(ws + ((l & 1) ? OFF_Y : OFF_X));
        bf16_t* OTH = (bf16_t*)(ws + ((l & 1) ? OFF_X : OFF_Y));
        if (kind == 0) {
            const float* c_ctx = P.in[4]; const float* cvec = P.in[3];
            LAS float* in_s = (LAS float*)lds; LAS float* red = in_s + 9 * 1024;
            for (int e = t; e < 9 * 1024; e += NTHREADS) { const int j = e >> 10, dd = e & 1023; const float c = (j == 0) ? c_ctx[dd] : cvec[(j - 1) * 1024 + dd]; in_s[e] = silu(c); }
            __syncthreads();
            for (int it = bx; it < 4 * 48; it += G) { const int ll = it / 48, nb = it % 48;
                gemv9_item(in_s, red, P.in[6] + (size_t)ll * 1024 * 3072, 3072, 0, P.in[7] + ll * 3072, (float*)(ws + OFF_MOD) + (size_t)ll * 9 * 3072, 3072, nb * 64); }
            __syncthreads();
            float* ROWSQ = (float*)(ws + OFF_ROWSQ);
            if (bx == 0) { ((unsigned*)(ws + OFF_CTR))[t] = 0u; ((unsigned*)(ws + OFF_CTR))[t + 512] = 0u; }
            for (int e = bx * NTHREADS + t; e < 5 * MTOT; e += G * NTHREADS) ROWSQ[e] = 0.f;
            bf16_t* TAB = (bf16_t*)(ws + OFF_TAB);
            for (int e = bx * NTHREADS + t; e < 188416; e += G * NTHREADS) {
                float v;
                if (e < 32768) { const int n = e >> 7, ch = e & 127; const int m = ((n & 127) * ch) & 127; v = (n < 128) ? cospif(m * (2.0f / 128.0f)) : -sinpif(m * (2.0f / 128.0f)); }
                else if (e < 49152) { const int i = e - 32768, rr = i >> 7, kk = i & 127; const int m = ((rr & 63) * (kk & 63)) & 63; const float c = cospif(m * (2.0f / 64.0f)), sn = sinpif(m * (2.0f / 64.0f));
                    v = (rr < 64) ? (kk < 64 ? c : sn) : (kk < 64 ? -sn : c); }
                else if (e < 57344) { const int i = e - 49152, rr = i >> 7, kk = i & 127; const int m = (rr * (kk & 63)) & 63; v = (kk < 64) ? cospif(m * (2.0f / 64.0f)) : sinpif(m * (2.0f / 64.0f)); }
                else { const int i = e - 57344, rr = i >> 9, kk = i & 511; const int m = (rr * (kk & 255)) & 255; v = (kk < 256) ? cospif(m * (2.0f / 256.0f)) : sinpif(m * (2.0f / 256.0f)); }
                TAB[e] = (bf16_t)f2bf(v);
            }
            __syncthreads();
            transpose_seg(P.in[8], NIN, 1024, (bf16_t*)(ws + OFF_W1), N1, 1, (LAS float*)(lds + wid * 16384), gw, NGW, lane);
        } else if (kind == 1) {
            const float* w_in = P.in[8];
            float* MOD = (float*)(ws + OFF_MOD);
            {
                volatile LAS unsigned* rk = (volatile LAS unsigned*)(lds + 140000);
                if (t == 0) rk[0] = atomicAdd((unsigned*)(ws + OFF_CTR) + xcc, 1u);
                __syncthreads();
                myrank = __builtin_amdgcn_readfirstlane((int)rk[0]);
            }
            LAS float* in_s = (LAS float*)lds; LAS float* red = in_s + 9 * 1024;
            for (int it = bx; it < 4 * 124; it += G) {
                const int ll = it / 124, nb = it % 124;
                __syncthreads();
                for (int e = t; e < 9 * 1024; e += NTHREADS) { const int j = e >> 10, dd = e & 1023; in_s[e] = MOD[((size_t)ll * 9 + j) * 3072 + dd]; }
                __syncthreads();
                if (nb < 76) gemv9_item(in_s, red, w_in + (size_t)ll * 1024 * NIN, NIN, 1, nullptr, (float*)(ws + OFF_SW1) + (size_t)ll * 9 * N1, N1, nb * 64);
                else gemv9_item(in_s, red, w_in + (size_t)ll * 1024 * NIN, NIN, 2, nullptr, (float*)(ws + OFF_SWG) + (size_t)ll * 9 * NGATE, NGATE, (nb - 76) * 64);
            }
            bf16_t* HS0 = (bf16_t*)(ws + OFF_X);
            float* ROWSQ = (float*)(ws + OFF_ROWSQ);
            const float* x_prompt = P.in[0]; const float* x_sample = P.in[1]; const float* ln_g = P.in[5];
            for (int row = gw; row < MTOT; row += NGW) {
                const float* xr = row < MCTX ? x_prompt + (size_t)row * DM : x_sample + (size_t)(row - MCTX) * DM;
                const int bidx = bidx_of_row(row);
                f32x4 v[4]; float sq = 0.f;
#pragma unroll
                for (int j = 0; j < 4; ++j) { v[j] = *(const f32x4*)(xr + j * 256 + lane * 4); sq += (v[j][0] * v[j][0] + v[j][1] * v[j][1]) + (v[j][2] * v[j][2] + v[j][3] * v[j][3]); }
#pragma unroll
                for (int o = 1; o < 64; o <<= 1) sq += __shfl_xor(sq, o);
                if (lane == 0) ROWSQ[row] = sq;
#pragma unroll
                for (int j = 0; j < 4; ++j) { const int col = j * 256 + lane * 4;
                    const f32x4 lg = *(const f32x4*)(ln_g + col); const f32x4 sc = *(const f32x4*)(MOD + (size_t)bidx * 3072 + 1024 + col);
                    const f32x4 y = v[j] * lg * (sc + 1.0f); u32x2 w; w.x = pk2(y[0], y[1]); w.y = pk2(y[2], y[3]); *(u32x2*)(HS0 + (size_t)row * DM + col) = w; }
            }
        } else if (kind == 3) {
            LAS float* scr = (LAS float*)(lds + wid * 16384);
            const float* w_in = P.in[8];
            if (l + 1 < NLAYER) transpose_seg(w_in + (size_t)(l + 1) * 1024 * NIN, NIN, 1024, (bf16_t*)(ws + OFF_W1), N1, 1, scr, gw, NGW, lane);
            transpose_seg(w_in + (size_t)l * 1024 * NIN, NIN, 1024, (bf16_t*)(ws + OFF_WG), NGATE, 2, scr, gw, NGW, lane);
            for (int b = 0; b < 3; ++b) transpose_seg(P.in[16] + ((size_t)l * 3 + b) * 512 * 1024, 1024, 512, (bf16_t*)(ws + OFF_WBR) + (size_t)b * 1024 * 512, 1024, 0, scr, gw, NGW, lane);
            transpose_seg(P.in[17] + (size_t)l * 1024 * 1024, 1024, 1024, (bf16_t*)(ws + OFF_WOUT), 1024, 0, scr, gw, NGW, lane);
            __syncthreads();
            const bool dryrt = (P.out != nullptr);
            for (int rep = (DUP_BI ? 0 : 1); rep < 2; ++rep) {
                const bool dry = (rep == 0) && dryrt;
                for (int it = bx; it < 2304; it += G) d1_item(dry, lds, it, (bf16_t*)(ws + OFF_QKV), (const bf16_t*)(ws + OFF_HALO), (const float*)(ws + OFF_BD), P.in[9] + (size_t)l * 3 * 1536, (float*)(ws + OFF_GB), (bf16_t*)(ws + OFF_TQ), P.in[10] + l * 8, P.in[11] + l * 8);
                for (int it = bx; it < 1152; it += G) sgu_item(dry, lds, it, OTH, (bf16_t*)(ws + OFF_UBZ), P.in[13] + l * 512, P.in[14] + (size_t)l * 4 * 16384, P.in[15] + l * 512);
                f1_load_tables(lds, (const bf16_t*)(ws + OFF_TAB));
                for (int it = bx; it < 2304; it += G) f1_item(dry, lds, it, (bf16_t*)(ws + OFF_XC), (bf16_t*)(ws + OFF_IM));
            }
        } else if (kind == 4) {
            bf16_t* OF = OTH; bf16_t* OB = OTH + (size_t)MTOT * 512;
            for (int rep = 0; rep < (DUP_CHAIN ? 2 : 1); ++rep)
            for (int it = bx; it < 768; it += G) { chain_item(lds, it, l, (const bf16_t*)(ws + OFF_QKV), (const bf16_t*)(ws + OFF_TQ), (const float*)(ws + OFF_GB), OF, OB, P.in[2], out + (size_t)MTOT * DM); __syncthreads(); }
            {
                LAS bf16_t* CSs = (LAS bf16_t*)lds; const bf16_t* CS64 = (const bf16_t*)(ws + OFF_TAB) + TAB_CS64 / 2;
                for (int e = t; e < 64 * 16; e += NTHREADS) { const int rr = e >> 4, c8 = (e & 15) * 8; *(LAS u32x4*)(CSs + rr * 136 + c8) = *(const u32x4*)(CS64 + rr * 128 + c8); }
                __syncthreads();
            }
            const bool dryrt = (P.out != nullptr);
            for (int rep = (DUP_F3 ? 0 : 1); rep < 2; ++rep) {
                const bool dry = (rep == 0) && dryrt;
                for (int it = bx; it < 2048; it += G) f3_latent_item(dry, lds, it, (bf16_t*)(ws + OFF_XC), (const bf16_t*)(ws + OFF_IM), (const bf16_t*)(ws + OFF_ZC));
                for (int it = bx; it < 256; it += G) f3_context_item(dry, lds, it, (bf16_t*)(ws + OFF_XC), (const bf16_t*)(ws + OFF_IM), (const bf16_t*)(ws + OFF_ZC), (const bf16_t*)(ws + OFF_TAB) + TAB_CS256 / 2, (bf16_t*)(ws + OFF_SPARE));
            }
        } else if (kind == 8) {
            const float* rowsq = (const float*)(ws + OFF_ROWSQ) + (size_t)4 * MTOT; const float* final_g = P.in[18];
            for (int row = gw; row < MTOT; row += NGW) {
                const float ri = rsqrtf(rowsq[row] * (1.0f / DM) + EPS);
#pragma unroll
                for (int j = 0; j < 4; ++j) { const int col = j * 256 + lane * 4; float* p = out + (size_t)row * DM + col;
                    const f32x4 v = *(const f32x4*)p; const f32x4 g = *(const f32x4*)(final_g + col); *(f32x4*)p = v * ri * g; }
            }
        } else {
            if (kind == 5) {
                const bf16_t* OF = OTH; const bf16_t* OB = OTH + (size_t)MTOT * 512; bf16_t* ZA = (bf16_t*)(ws + OFF_ZA);
                const float* og = P.in[12] + l * 128;
                for (int row = gw; row < MCTX; row += NGW) *(u32x4*)((bf16_t*)(ws + OFF_XC) + (size_t)row * 512 + lane * 8) = *(const u32x4*)((const bf16_t*)(ws + OFF_SPARE) + (size_t)row * 512 + lane * 8);
                for (int row = gw; row < MTOT; row += NGW) {
                    const size_t off = (size_t)row * 512 + lane * 8;
                    const u32x4 a = *(const u32x4*)(OF + off), b = *(const u32x4*)(OB + off), z = *(const u32x4*)(ZA + off);
                    f32x4 o0 = (f32x4){bflo(a.x) + bflo(b.x), bfhi(a.x) + bfhi(b.x), bflo(a.y) + bflo(b.y), bfhi(a.y) + bfhi(b.y)};
                    f32x4 o1 = (f32x4){bflo(a.z) + bflo(b.z), bfhi(a.z) + bfhi(b.z), bflo(a.w) + bflo(b.w), bfhi(a.w) + bfhi(b.w)};
                    float sq = (o0[0] * o0[0] + o0[1] * o0[1]) + (o0[2] * o0[2] + o0[3] * o0[3]) + (o1[0] * o1[0] + o1[1] * o1[1]) + (o1[2] * o1[2] + o1[3] * o1[3]);
                    sq += __shfl_xor(sq, 1); sq += __shfl_xor(sq, 2); sq += __shfl_xor(sq, 4); sq += __shfl_xor(sq, 8);
                    const float ri = rsqrtf(sq * (1.0f / 128.0f) + EPS);
                    const int c0 = (lane & 15) * 8;
                    const f32x4 g0 = *(const f32x4*)(og + c0), g1 = *(const f32x4*)(og + c0 + 4);
                    const f32x4 z0 = (f32x4){bflo(z.x), bfhi(z.x), bflo(z.y), bfhi(z.y)}, z1 = (f32x4){bflo(z.z), bfhi(z.z), bflo(z.w), bfhi(z.w)};
                    o0 = o0 * ri * g0 * z0; o1 = o1 * ri * g1 * z1;
                    u32x4 w; w.x = pk2(o0[0], o0[1]); w.y = pk2(o0[2], o0[3]); w.z = pk2(o1[0], o1[1]); w.w = pk2(o1[2], o1[3]);
                    *(u32x4*)(ZA + off) = w;
                }
                __syncthreads();
            }
            if (step == 2) {
                const unsigned* ctr = (const unsigned*)(ws + OFF_CTR);
                bool ok = (G % 8) == 0 && xcc < 8;
                for (int j = 0; j < 8; ++j) ok = ok && ((int)__hip_atomic_load(ctr + j, __ATOMIC_RELAXED, __HIP_MEMORY_SCOPE_AGENT) == G / 8);
                cvirt = ok ? myrank * 8 + xcc : bx;
                fastbar = ok;
            }
            pg8::Sched S; S.nM = MTOT / 256; S.G = G; S.c = cvirt; S.nsub = 1; S.K = 1024; S.bsub = 0;
            S.A0 = (const char*)HS; S.asub = 0;
            EpiAll E; E.layer = l; E.ws = ws; E.out = out; E.xp = P.in[0]; E.xs = P.in[1];
            E.lng_next = P.in[5] + (size_t)(l + 1 < NLAYER ? l + 1 : l) * DM; E.hs = HS; E.oth = OTH;
            if (kind == 2) { E.mode = 0; S.nN = N1 / 256; S.B0 = (const char*)(ws + OFF_W1); }
            else if (kind == 5) { E.mode = 1; S.nN = NGATE / 256; S.B0 = (const char*)(ws + OFF_WG); }
            else if (kind == 6) { E.mode = 2; S.nN = 4; S.nsub = 3; S.K = 512; S.A0 = (const char*)(ws + OFF_ZA); S.asub = RB;
                S.B0 = (const char*)(ws + OFF_WBR); S.bsub = (size_t)1024 * 512 * 2; }
            else { E.mode = 3; S.nN = 4; S.B0 = (const char*)(ws + OFF_WOUT); }
            S.nwg = S.nM * S.nN;
            for (int rep = ((DUP_GEMM && kind != 7) ? 0 : 1); rep < 2; ++rep) { E.dry = (rep == 0) && (P.out != nullptr); pg8::gemm_phase<EpiAll>(lds, S, E); __syncthreads(); }
        }
        if (!fastbar) grid.sync();
        else {
            unsigned* ctr = (unsigned*)(P.ws + OFF_CTR);
            asm volatile("s_waitcnt vmcnt(0)" ::: "memory");
            __syncthreads();
            if (threadIdx.x == 0) {
                const unsigned nloc = (unsigned)(G / 8);
                unsigned* xsub = ctr + 128 + 32 * xcc; unsigned* xgen = ctr + 384 + 32 * xcc; unsigned* top = ctr + 640; unsigned* topgen = ctr + 672;
                const unsigned old = __hip_atomic_fetch_add(xsub, 1u, __ATOMIC_RELAXED, __HIP_MEMORY_SCOPE_AGENT);
                const unsigned gen = old / nloc;
                if (old + 1u == (gen + 1u) * nloc) {
                    __builtin_amdgcn_fence(__ATOMIC_RELEASE, "agent");
                    asm volatile("s_waitcnt vmcnt(0)" ::: "memory");
                    const unsigned og = __hip_atomic_fetch_add(top, 1u, __ATOMIC_RELAXED, __HIP_MEMORY_SCOPE_AGENT);
                    const unsigned tg = og / 8u;
                    if (og + 1u == (tg + 1u) * 8u) __hip_atomic_fetch_add(topgen, 1u, __ATOMIC_RELAXED, __HIP_MEMORY_SCOPE_AGENT);
                    else { while (__hip_atomic_load(topgen, __ATOMIC_RELAXED, __HIP_MEMORY_SCOPE_AGENT) == tg) __builtin_amdgcn_s_sleep(1); }
                    __builtin_amdgcn_fence(__ATOMIC_ACQUIRE, "agent");
                    __hip_atomic_fetch_add(xgen, 1u, __ATOMIC_RELAXED, __HIP_MEMORY_SCOPE_AGENT);
                    asm volatile("s_waitcnt vmcnt(0)" ::: "memory");
                } else {
                    while (__hip_atomic_load(xgen, __ATOMIC_RELAXED, __HIP_MEMORY_SCOPE_AGENT) == gen) __builtin_amdgcn_s_sleep(1);
                    __builtin_amdgcn_fence(__ATOMIC_ACQUIRE, "agent");
                    asm volatile("s_waitcnt vmcnt(0)" ::: "memory");
                }
            }
            __syncthreads();
        }
    }
}

extern "C" void kernel_launch(void* const* d_in, const int* in_sizes, int n_in, void* d_out, int out_size, void* d_ws, size_t ws_size, hipStream_t stream) {
    static int grid_blocks = 0;
    if (grid_blocks == 0) {
        if (n_in != 19 || ws_size < WS_END) { fprintf(stderr, "kernel_launch: unexpected inputs (n_in %d, ws %zu, need %zu)\n", n_in, ws_size, (size_t)WS_END); grid_blocks = -1; return; }
        int dev = 0, cus = 0, per_cu = 0;
        hipGetDevice(&dev);
        hipDeviceGetAttribute(&cus, hipDeviceAttributeMultiprocessorCount, dev);
        if (hipFuncSetAttribute((const void*)mega_fwd, hipFuncAttributeMaxDynamicSharedMemorySize, LDS_BYTES) != hipSuccess) { fprintf(stderr, "kernel_launch: hipFuncSetAttribute failed\n"); grid_blocks = -1; return; }
        if (hipOccupancyMaxActiveBlocksPerMultiprocessor(&per_cu, (const void*)mega_fwd, NTHREADS, LDS_BYTES) != hipSuccess || per_cu < 1) { fprintf(stderr, "kernel_launch: occupancy query gave %d\n", per_cu); per_cu = 1; }
        (void)hipGetLastError();
        grid_blocks = cus * per_cu;
    }
    if (grid_blocks < 0) return;
    Params p{};
    for (int i = 0; i < 19; ++i) p.in[i] = (const float*)d_in[i];
    p.out = (float*)d_out; p.ws = (unsigned char*)d_ws;
    void* args[] = {&p};
    hipError_t e = hipLaunchCooperativeKernel((const void*)mega_fwd, dim3(grid_blocks), dim3(NTHREADS), args, LDS_BYTES, stream);
    if (e != hipSuccess) fprintf(stderr, "cooperative launch failed: %s (grid %d)\n", hipGetErrorString(e), grid_blocks);
}
```

```cpp
#include <hip/hip_runtime.h>
#include <hip/hip_cooperative_groups.h>
#include <cstdio>
namespace cg = cooperative_groups;

#define DI __device__ __forceinline__
#define LAS __attribute__((address_space(3)))
typedef unsigned short bf16_t;
typedef short bf16x8 __attribute__((ext_vector_type(8)));
typedef float f32x4 __attribute__((ext_vector_type(4)));
typedef unsigned u32x4 __attribute__((ext_vector_type(4)));
typedef unsigned u32x2 __attribute__((ext_vector_type(2)));

constexpr int DM = 1024, MCTX = 4096, MTOT = 36864, NLAYER = 4;
constexpr int N1 = 4864, NGATE = 3072, NIN = 7696;
constexpr float EPS = 1e-6f;
constexpr int NTHREADS = 512;
constexpr int LDS_BYTES = 147456;
#ifndef DUP_GEMM
#define DUP_GEMM 0
#endif
#ifndef DUP_CHAIN
#define DUP_CHAIN 0
#endif
#ifndef DUP_P0
#define DUP_P0 0
#endif
#ifndef DUP_BI
#define DUP_BI 0
#endif
#ifndef DUP_F3
#define DUP_F3 0
#endif

constexpr size_t RB = (size_t)MTOT * 512 * 2;
constexpr size_t OFF_MOD = 0;
constexpr size_t OFF_SW1 = 524288;
constexpr size_t OFF_SWG = 1310720;
constexpr size_t OFF_ROWSQ = 1835008;
constexpr size_t OFF_CTR = 1830912;
constexpr size_t OFF_BD = 2621440;
constexpr size_t OFF_GB = 5242880;
constexpr size_t OFF_HALO = 7864320;
constexpr size_t OFF_TAB = 11534336;
constexpr size_t TAB_FCH = 0, TAB_M2 = 65536, TAB_CS64 = 98304, TAB_CS256 = 114688;
constexpr size_t OFF_W1 = 12582912;
constexpr size_t OFF_WG = OFF_W1 + (size_t)N1 * 1024 * 2;
constexpr size_t OFF_WBR = OFF_WG + (size_t)NGATE * 1024 * 2;
constexpr size_t OFF_WOUT = OFF_WBR + (size_t)3 * 1024 * 512 * 2;
constexpr size_t OFF_X = OFF_WOUT + (size_t)1024 * 1024 * 2;
constexpr size_t OFF_Y = OFF_X + 2 * RB;
constexpr size_t OFF_G = OFF_Y + 2 * RB;
constexpr size_t OFF_QKV = OFF_G, OFF_TQ = OFF_G + 3 * RB, OFF_IM = OFF_G + 4 * RB, OFF_ZC = OFF_G + 5 * RB;
constexpr size_t OFF_ZA = OFF_G + 6 * RB, OFF_UBZ = OFF_ZA + RB, OFF_XC = OFF_UBZ + RB, OFF_SPARE = OFF_XC + RB, WS_END = OFF_SPARE + (size_t)MCTX * 512 * 2;

struct Params {
    const float* in[19];
    float* out;
    unsigned char* ws;
};

DI unsigned f2bf(float f) { const __bf16 b = (__bf16)f; return (unsigned)__builtin_bit_cast(unsigned short, b); }
typedef float f32x2_t __attribute__((ext_vector_type(2)));
typedef __bf16 bf16x2_t __attribute__((ext_vector_type(2)));
DI unsigned pk2(float lo, float hi) { const f32x2_t v = {lo, hi}; const bf16x2_t b = __builtin_convertvector(v, bf16x2_t); return __builtin_bit_cast(unsigned, b); }
DI float bflo(unsigned u) { return __builtin_bit_cast(float, u << 16); }
DI float bfhi(unsigned u) { return __builtin_bit_cast(float, u & 0xffff0000u); }
DI float bf2f(bf16_t h) { return __builtin_bit_cast(float, ((unsigned)h) << 16); }
DI float sigm(float x) { return __builtin_amdgcn_rcpf(1.0f + __expf(-x)); }
DI float silu(float x) { return x * sigm(x); }
DI float softplus(float x) { return fmaxf(x, 0.f) + log1pf(__expf(-fabsf(x))); }
DI int tid_opaque() { int t = threadIdx.x; asm volatile("" : "+v"(t)); return t; }
constexpr int PTAB_OFF = 147456 - 256;
DI void* ld_ptr(LAS unsigned char* lds, int i) {
    const volatile LAS unsigned* p = (const volatile LAS unsigned*)(lds + PTAB_OFF) + 2 * i;
    const unsigned lo = __builtin_amdgcn_readfirstlane(p[0]), hi = __builtin_amdgcn_readfirstlane(p[1]);
    return (void*)(((unsigned long long)hi << 32) | lo);
}
DI int bidx_of_row(int row) { return row < MCTX ? 0 : 1 + ((row - MCTX) >> 12); }

DI f32x4 mfma16(bf16x8 a, bf16x8 b, f32x4 c) { return __builtin_amdgcn_mfma_f32_16x16x32_bf16(a, b, c, 0, 0, 0); }
DI f32x4 mma_tile(f32x4 acc, const LAS bf16_t* A, int lda, const LAS bf16_t* Bt, int ldb, int K, int lane) {
    const int r = lane & 15, q = lane >> 4;
    const LAS bf16_t* ap = A + r * lda + q * 8;
    const LAS bf16_t* bp = Bt + r * ldb + q * 8;
    for (int k0 = 0; k0 < K; k0 += 32) {
        bf16x8 a = *(const LAS bf16x8*)(ap + k0);
        bf16x8 b = *(const LAS bf16x8*)(bp + k0);
        acc = mfma16(a, b, acc);
    }
    return acc;
}

namespace pg8 {
constexpr int BM = 256, BK = 64, HALF = 128, HTB = HALF * BK * 2, NXCD = 8, WGM = 8;
DI int lds_byte(int r, int c) { const int st = (r >> 4) * 2 + (c >> 5), rr = r & 15, cc = c & 31, ob = rr * 64 + cc * 2; return st * 1024 + (ob ^ (((ob >> 9) & 1) << 5)); }
DI void stage_rc(int b, int& R, int& C) { const int st = b / 1024, sb = b % 1024, swz = sb ^ (((sb >> 9) & 1) << 5); R = (st >> 1) * 16 + swz / 64; C = (st & 1) * 32 + (swz % 64) / 2; }
DI int perm32(int rho) { const int n = rho >> 4, i = rho & 15; return 8 * (i >> 2) + 4 * n + (i & 3); }
struct Unit { int pm, pn, br; };
struct Sched {
    int nM, nN, nwg, G, c, nsub, K;
    const char* A0; size_t asub; const char* B0; size_t bsub;
    const float* pre_rq; const float* pre_sw; int pre_ld; bool pre;
    DI bool next(int i, Unit& u) const {
        const int ib = i / nsub; u.br = i - ib * nsub;
        const long L = (long)ib * G + c; if (L >= nwg) return false;
        int wgid = (int)L; { const int q = nwg / NXCD, r = nwg % NXCD, xcd = wgid % NXCD, off = wgid / NXCD; wgid = (xcd < r ? xcd * (q + 1) : r * (q + 1) + (xcd - r) * q) + off; }
        const int nig = WGM * nN, gid = wgid / nig, fm = gid * WGM, gsz = (nM - fm) < WGM ? (nM - fm) : WGM;
        u.pm = fm + ((wgid % nig) % gsz); u.pn = (wgid % nig) / gsz; return true;
    }
    DI const char* aptr(const Unit& u) const { return A0 + (size_t)u.br * asub + (size_t)u.pm * (size_t)(BM * 2) * K; }
    DI const char* bptr(const Unit& u) const { return B0 + (size_t)u.br * bsub + (size_t)u.pn * (size_t)(BM * 2) * K; }
};
typedef f32x4 acc_t[2][2][4][2];

template <class Epi>
DI void gemm_phase(LAS unsigned char* lds, const Sched& S, const Epi& E) {
    const int tid = tid_opaque(), wid = __builtin_amdgcn_readfirstlane(tid >> 6), lane = tid & 63, wr = wid >> 2, wc = wid & 3, fr = lane & 15, fq = lane >> 4;
    const int K = S.K, nt = K / BK;
    unsigned voffA[2], voffB[2];
#pragma unroll
    for (int i = 0; i < 2; ++i) { int R, C; stage_rc(tid * 16 + i * 8192, R, C); const int Rb = (R & ~31) + perm32(R & 31);
        voffA[i] = (unsigned)(R * K + C) * 2u; voffB[i] = (unsigned)(Rb * K + C) * 2u; }
    const size_t kstep = (size_t)(BK * 2);
    const size_t hstep = (size_t)HALF * K * 2;
    const unsigned ldsw = (unsigned)wid * 1024u;
    const int aoff = lds_byte(wr * 64 + fr, fq * 8), boff = lds_byte(wc * 32 + fr, fq * 8);
#define PG8_SA(b, h) (((b) * 2 + (h)) * HTB)
#define PG8_SB(b, h) ((4 + (b) * 2 + (h)) * HTB)
#define PG8_STAGE(bufoff, gbase, voff) do { _Pragma("unroll") for (int _i = 0; _i < 2; ++_i) \
        __builtin_amdgcn_global_load_lds((const unsigned*)((const char*)(gbase) + (voff)[_i]), (LAS unsigned*)(lds + (bufoff) + ldsw + _i * 8192), 16, 0, 0); } while (0)
#define PG8_LDA(dst, b, h) do { _Pragma("unroll") for (int m = 0; m < 4; ++m) _Pragma("unroll") for (int k = 0; k < 2; ++k) dst[m][k] = *(const LAS bf16x8*)(lds + PG8_SA(b, h) + aoff + m * 2048 + k * 1024); } while (0)
#define PG8_LDB(dst, b, h) do { _Pragma("unroll") for (int n = 0; n < 2; ++n) _Pragma("unroll") for (int k = 0; k < 2; ++k) dst[n][k] = *(const LAS bf16x8*)(lds + PG8_SB(b, h) + boff + n * 2048 + k * 1024); } while (0)
#define PG8_MMA(ai, bj, At, Bt) do { __builtin_amdgcn_s_setprio(1); _Pragma("unroll") for (int m = 0; m < 4; ++m) _Pragma("unroll") for (int n = 0; n < 2; ++n) _Pragma("unroll") for (int k = 0; k < 2; ++k) \
        acc[ai][bj][m][n] = __builtin_amdgcn_mfma_f32_16x16x32_bf16(Bt[n][k], At[m][k], acc[ai][bj][m][n], 0, 0, 0); __builtin_amdgcn_s_setprio(0); } while (0)
#define PG8_WAIT_V(n) asm volatile("s_waitcnt vmcnt(" #n ")" ::: "memory")
#define PG8_WAIT_L(n) asm volatile("s_waitcnt lgkmcnt(" #n ")" ::: "memory")
#define PG8_BAR __builtin_amdgcn_s_barrier()
#define PG8_SCHED __builtin_amdgcn_sched_barrier(0)
    Unit cur, nxt; int ui = 0;
    if (!S.next(0, cur)) return;
    acc_t acc;
#pragma unroll
    for (int a = 0; a < 2; ++a)
#pragma unroll
        for (int b = 0; b < 2; ++b)
#pragma unroll
            for (int m = 0; m < 4; ++m)
#pragma unroll
                for (int n = 0; n < 2; ++n) acc[a][b][m][n] = (f32x4){0.f, 0.f, 0.f, 0.f};
    bf16x8 At[4][2], B0[2][2], B1[2][2];
    const char* cA = S.aptr(cur); const char* cB = S.bptr(cur);
    PG8_STAGE(PG8_SB(0, 0), cB, voffB); PG8_STAGE(PG8_SA(0, 0), cA, voffA); PG8_STAGE(PG8_SB(0, 1), cB + hstep, voffB); PG8_STAGE(PG8_SA(0, 1), cA + hstep, voffA);
    if (wr == 1) PG8_BAR;
    PG8_WAIT_V(4); PG8_BAR;
    PG8_STAGE(PG8_SB(1, 0), cB + kstep, voffB); PG8_STAGE(PG8_SA(1, 0), cA + kstep, voffA); PG8_STAGE(PG8_SB(1, 1), cB + hstep + kstep, voffB);
    PG8_WAIT_V(6); PG8_BAR;
    for (;;) {
        const bool has_next = S.next(ui + 1, nxt);
        const char* nA = has_next ? S.aptr(nxt) : cA; const char* nB = has_next ? S.bptr(nxt) : cB;
        LAS unsigned char* epi_lds = lds + 131072 + (ui & 1) * 2048;
        if (S.pre && wid == 0) {
            const float* rq = S.pre_rq + cur.pm * 256 + lane * 4;
            const float* sw = S.pre_sw + (size_t)bidx_of_row(cur.pm * 256) * S.pre_ld + cur.pn * 256 + lane * 4;
            __builtin_amdgcn_global_load_lds((const unsigned*)rq, (LAS unsigned*)(epi_lds), 16, 0, 0);
            __builtin_amdgcn_global_load_lds((const unsigned*)sw, (LAS unsigned*)(epi_lds + 1024), 16, 0, 0);
        }
        for (int t = 0; t < nt; t += 2) {
            const bool last = (t == nt - 2);
            const char* a1 = cA + (size_t)(t + 1) * kstep;
            const char* a2 = last ? nA : cA + (size_t)(t + 2) * kstep; const char* b2 = last ? nB : cB + (size_t)(t + 2) * kstep;
            const char* a3 = a2 + kstep; const char* b3 = b2 + kstep;
            PG8_LDB(B0, 0, 0); PG8_SCHED; PG8_LDA(At, 0, 0); PG8_STAGE(PG8_SA(1, 1), a1 + hstep, voffA);
            PG8_WAIT_L(8); PG8_BAR; PG8_WAIT_L(0); PG8_MMA(0, 0, At, B0); PG8_BAR; PG8_SCHED;
            PG8_LDB(B1, 0, 1); PG8_STAGE(PG8_SB(0, 0), b2, voffB);
            PG8_BAR; PG8_WAIT_L(0); PG8_MMA(0, 1, At, B1); PG8_BAR;
            PG8_LDA(At, 0, 1); PG8_STAGE(PG8_SA(0, 0), a2, voffA);
            PG8_BAR; PG8_WAIT_L(0); PG8_MMA(1, 0, At, B0); PG8_BAR; PG8_SCHED;
            PG8_STAGE(PG8_SB(0, 1), b2 + hstep, voffB);
            PG8_WAIT_V(6); PG8_BAR; PG8_MMA(1, 1, At, B1); PG8_BAR;
            PG8_LDB(B0, 1, 0); PG8_SCHED; PG8_LDA(At, 1, 0); PG8_STAGE(PG8_SA(0, 1), a2 + hstep, voffA);
            PG8_WAIT_L(8); PG8_BAR; PG8_WAIT_L(0); PG8_MMA(0, 0, At, B0); PG8_BAR; PG8_SCHED;
            PG8_LDB(B1, 1, 1); PG8_STAGE(PG8_SB(1, 0), b3, voffB);
            PG8_BAR; PG8_WAIT_L(0); PG8_MMA(0, 1, At, B1); PG8_BAR;
            PG8_LDA(At, 1, 1); PG8_STAGE(PG8_SA(1, 0), a3, voffA);
            PG8_BAR; PG8_WAIT_L(0); PG8_MMA(1, 0, At, B0); PG8_BAR; PG8_SCHED;
            PG8_STAGE(PG8_SB(1, 1), b3 + hstep, voffB);
            PG8_WAIT_V(6); PG8_BAR; PG8_MMA(1, 1, At, B1); PG8_BAR;
        }
        E(acc, cur, wr, wc, fr, fq, epi_lds);
        if (!has_next) break;
#pragma unroll
        for (int a = 0; a < 2; ++a)
#pragma unroll
            for (int b = 0; b < 2; ++b)
#pragma unroll
                for (int m = 0; m < 4; ++m)
#pragma unroll
                    for (int n = 0; n < 2; ++n) acc[a][b][m][n] = (f32x4){0.f, 0.f, 0.f, 0.f};
        cur = nxt; cA = nA; cB = nB; ++ui;
    }
    PG8_WAIT_V(0);
    if (wr == 0) PG8_BAR;
    PG8_BAR;
#undef PG8_SA
#undef PG8_SB
#undef PG8_STAGE
#undef PG8_LDA
#undef PG8_LDB
#undef PG8_MMA
#undef PG8_WAIT_V
#undef PG8_WAIT_L
#undef PG8_BAR
#undef PG8_SCHED
}
}
using pg8::Unit;
using pg8::acc_t;

DI u32x4 pk8(f32x4 a, f32x4 b) { u32x4 w; w.x = pk2(a[0], a[1]); w.y = pk2(a[2], a[3]); w.z = pk2(b[0], b[1]); w.w = pk2(b[2], b[3]); return w; }
struct EpiAll {
    int mode, layer; bool dry;
    unsigned char* ws; float* out; const float* xp; const float* xs; const float* lng_next;
    bf16_t* hs; bf16_t* oth;
    DI void operator()(const acc_t& acc, const Unit& u, int wr, int wc, int fr_in, int fq_in, const LAS unsigned char* pre) const {
        if (dry) return;
        int fr = fr_in, fq = fq_in; asm volatile("" : "+v"(fr), "+v"(fq));
        const int pn = u.pn, br = u.br;
        const int row0 = u.pm * 256 + wr * 64 + fr, cin = wc * 32 + 8 * fq;
        const int bidx = bidx_of_row(u.pm * 256);
        if (mode == 0) {
            const LAS float* rowsq = (const LAS float*)pre;
            const LAS float* sw = (const LAS float*)(pre + 1024) + cin;
            f32x4 sv[2][2];
#pragma unroll
            for (int bj = 0; bj < 2; ++bj)
#pragma unroll
                for (int n = 0; n < 2; ++n) sv[bj][n] = *(const LAS f32x4*)(sw + bj * 128 + 4 * n);
            size_t doff; int tb, ldd; bool act;
            if (pn < 6) { doff = OFF_QKV; tb = pn; ldd = 1536; act = false; }
            else if (pn < 8) { doff = OFF_ZA; tb = pn - 6; ldd = 512; act = true; }
            else if (pn < 12) { doff = OFF_UBZ; tb = 0; ldd = 512; act = false; }
            else if (pn < 14) { doff = (layer & 1) ? OFF_X : OFF_Y; tb = pn - 12; ldd = 512; act = false; }
            else if (pn < 16) { doff = OFF_XC; tb = pn - 14; ldd = 512; act = false; }
            else { doff = OFF_ZC; tb = pn - 16; ldd = 512; act = true; }
            bf16_t* dst = (bf16_t*)(ws + doff) + tb * 256 + cin;
            bf16_t* HALO = (bf16_t*)(ws + OFF_HALO) + pn * 256 + cin;
#pragma unroll
            for (int ai = 0; ai < 2; ++ai) {
                float rq[4];
#pragma unroll
                for (int m = 0; m < 4; ++m) rq[m] = rowsq[wr * 64 + fr + ai * 128 + m * 16];
#pragma unroll
                for (int m = 0; m < 4; ++m) {
                    const int row = row0 + ai * 128 + m * 16;
                    const float rinv = rsqrtf(rq[m] * (1.0f / DM) + EPS);
                    if (pn >= 8 && pn < 12) {
                        f32x4 o[2];
#pragma unroll
                        for (int n = 0; n < 2; ++n) {
                            const f32x4 uu = acc[ai][0][m][n] * rinv + sv[0][n], zz = acc[ai][1][m][n] * rinv + sv[1][n];
#pragma unroll
                            for (int j = 0; j < 4; ++j) o[n][j] = uu[j] * silu(zz[j]);
                        }
                        *(u32x4*)(dst + (size_t)row * 512 + (pn - 8) * 128) = pk8(o[0], o[1]);
                    } else if (pn == 18) {
                        if (wc == 0 && fq < 2) {
#pragma unroll
                            for (int n = 0; n < 2; ++n) *(f32x4*)((float*)(ws + OFF_BD) + (size_t)row * 16 + 8 * fq + 4 * n) = acc[ai][0][m][n] * rinv + sv[0][n];
                        }
                    } else {
#pragma unroll
                        for (int bj = 0; bj < 2; ++bj) {
                            f32x4 a = acc[ai][bj][m][0] * rinv + sv[bj][0], b = acc[ai][bj][m][1] * rinv + sv[bj][1];
                            if (act) {
#pragma unroll
                                for (int j = 0; j < 4; ++j) { a[j] = silu(a[j]); b[j] = silu(b[j]); }
                            }
                            const u32x4 w = pk8(a, b);
                            *(u32x4*)(dst + (size_t)row * ldd + bj * 128) = w;
                            if (pn < 6) {
                                if ((row & 63) == 0) *(u32x4*)(HALO + ((size_t)(row >> 6) * 2 + 0) * 1536 + bj * 128) = w;
                                if ((row & 63) == 63) *(u32x4*)(HALO + ((size_t)(row >> 6) * 2 + 1) * 1536 + bj * 128) = w;
                            }
                        }
                    }
                }
                asm volatile("" ::: "memory");
            }
        } else if (mode == 1) {
            const LAS float* rowsq = (const LAS float*)pre;
            const LAS float* sw = (const LAS float*)(pre + 1024) + cin;
            bf16_t* GT = (bf16_t*)(ws + OFF_G) + pn * 256 + cin;
            f32x4 sv[2][2];
#pragma unroll
            for (int bj = 0; bj < 2; ++bj)
#pragma unroll
                for (int n = 0; n < 2; ++n) sv[bj][n] = *(const LAS f32x4*)(sw + bj * 128 + 4 * n);
#pragma unroll
            for (int ai = 0; ai < 2; ++ai) {
                float rq[4];
#pragma unroll
                for (int m = 0; m < 4; ++m) rq[m] = rowsq[wr * 64 + fr + ai * 128 + m * 16];
#pragma unroll
                for (int m = 0; m < 4; ++m) {
                    const int row = row0 + ai * 128 + m * 16;
                    const float rinv = rsqrtf(rq[m] * (1.0f / DM) + EPS);
#pragma unroll
                    for (int bj = 0; bj < 2; ++bj) {
                        f32x4 a = acc[ai][bj][m][0] * rinv + sv[bj][0], b = acc[ai][bj][m][1] * rinv + sv[bj][1];
#pragma unroll
                        for (int j = 0; j < 4; ++j) { a[j] = sigm(a[j]); b[j] = sigm(b[j]); }
                        *(u32x4*)(GT + (size_t)row * NGATE + bj * 128) = pk8(a, b);
                    }
                }
                asm volatile("" ::: "memory");
            }
        } else if (mode == 2) {
            const bf16_t* GT = (const bf16_t*)(ws + OFF_G) + br * 1024 + pn * 256 + cin;
            bf16_t* MG = hs + pn * 256 + cin;
#pragma unroll
            for (int hm = 0; hm < 4; ++hm) {
                const int ai = hm >> 1, mb = (hm & 1) * 2;
                u32x4 gc[2][2], pv[2][2];
#pragma unroll
                for (int mm = 0; mm < 2; ++mm)
#pragma unroll
                    for (int bj = 0; bj < 2; ++bj) gc[mm][bj] = *(const u32x4*)(GT + (size_t)(row0 + ai * 128 + (mb + mm) * 16) * NGATE + bj * 128);
                if (br > 0) {
                    bf16_t* p0 = MG + (size_t)(row0 + ai * 128 + mb * 16) * 1024;
                    asm volatile("global_load_dwordx4 %0, %4, off sc1\n\tglobal_load_dwordx4 %1, %4, off offset:256 sc1\n\t"
                                 "global_load_dwordx4 %2, %5, off sc1\n\tglobal_load_dwordx4 %3, %5, off offset:256 sc1\n\ts_waitcnt vmcnt(0)"
                                 : "=&v"(pv[0][0]), "=&v"(pv[0][1]), "=&v"(pv[1][0]), "=&v"(pv[1][1])
                                 : "v"(p0), "v"(p0 + 16 * 1024) : "memory");
                }
#pragma unroll
                for (int mm = 0; mm < 2; ++mm)
#pragma unroll
                    for (int bj = 0; bj < 2; ++bj) {
                        const u32x4 g = gc[mm][bj];
                        f32x4 a = acc[ai][bj][mb + mm][0] * (f32x4){bflo(g.x), bfhi(g.x), bflo(g.y), bfhi(g.y)};
                        f32x4 b = acc[ai][bj][mb + mm][1] * (f32x4){bflo(g.z), bfhi(g.z), bflo(g.w), bfhi(g.w)};
                        if (br > 0) {
                            const u32x4 p = pv[mm][bj];
                            a = a + (f32x4){bflo(p.x), bfhi(p.x), bflo(p.y), bfhi(p.y)};
                            b = b + (f32x4){bflo(p.z), bfhi(p.z), bflo(p.w), bfhi(p.w)};
                        }
                        *(u32x4*)(MG + (size_t)(row0 + ai * 128 + (mb + mm) * 16) * 1024 + bj * 128) = pk8(a, b);
                    }
                asm volatile("" ::: "memory");
            }
        } else {
            const float* hold = (layer == 0) ? (u.pm < 16 ? xp : xs - (size_t)MCTX * DM) : out;
            const float* gate = (const float*)(ws + OFF_MOD) + ((size_t)layer * 9 + bidx) * 3072 + 2048 + pn * 256 + cin;
            const float* gsc = (const float*)(ws + OFF_MOD) + ((size_t)(layer + 1 < NLAYER ? layer + 1 : layer) * 9 + bidx) * 3072 + 1024 + pn * 256 + cin;
            const float* lgn = lng_next + pn * 256 + cin;
            float* rsq = (float*)(ws + OFF_ROWSQ) + (size_t)(layer + 1) * MTOT;
            f32x4 gv[2][2], gs[2][2];
#pragma unroll
            for (int bj = 0; bj < 2; ++bj)
#pragma unroll
                for (int n = 0; n < 2; ++n) {
                    gv[bj][n] = *(const f32x4*)(gate + bj * 128 + 4 * n);
                    if (layer < 3) { const f32x4 lg = *(const f32x4*)(lgn + bj * 128 + 4 * n); const f32x4 sc = *(const f32x4*)(gsc + bj * 128 + 4 * n); gs[bj][n] = lg * (sc + 1.0f); }
                    else gs[bj][n] = (f32x4){0.f, 0.f, 0.f, 0.f};
                }
#pragma unroll
            for (int ai = 0; ai < 2; ++ai)
#pragma unroll
                for (int m = 0; m < 4; ++m) {
                    const int row = row0 + ai * 128 + m * 16;
                    float ss = 0.f;
#pragma unroll
                    for (int bj = 0; bj < 2; ++bj) {
                        const size_t off = (size_t)row * DM + pn * 256 + cin + bj * 128;
                        const f32x4 h0 = *(const f32x4*)(hold + off), h1 = *(const f32x4*)(hold + off + 4);
                        const f32x4 hn0 = h0 + gv[bj][0] * acc[ai][bj][m][0], hn1 = h1 + gv[bj][1] * acc[ai][bj][m][1];
                        *(f32x4*)(out + off) = hn0; *(f32x4*)(out + off + 4) = hn1;
                        ss += (hn0[0] * hn0[0] + hn0[1] * hn0[1]) + (hn0[2] * hn0[2] + hn0[3] * hn0[3]) + (hn1[0] * hn1[0] + hn1[1] * hn1[1]) + (hn1[2] * hn1[2] + hn1[3] * hn1[3]);
                        if (layer < 3) *(u32x4*)(oth + off) = pk8(hn0 * gs[bj][0], hn1 * gs[bj][1]);
                    }
                    ss += __shfl_xor(ss, 16); ss += __shfl_xor(ss, 32);
                    if (fq == 0) atomicAdd(rsq + row, ss);
                    if (m == 3) asm volatile("" ::: "memory");
                }
        }
    }
};

DI int colmap1(int n) {
    const int t = n >> 8, o = n & 255;
    if (t < 6) return n;
    if (t < 8) return 1552 + (n - 1536);
    if (t < 12) { const int i = t - 8; return o < 128 ? 2064 + 128 * i + o : 3088 + 128 * i + (o - 128); }
    if (t < 14) return 2576 + (n - 3072);
    if (t < 16) return 3600 + (n - 3584);
    if (t < 18) return 4112 + (n - 4096);
    return o < 16 ? 1536 + o : -1;
}
DI void transpose_item(const float* W, int Nsrc, int K, bf16_t* WT, int nblk, int mapkind, LAS float* scr, int item, int lane) {
    const int kb = item / nblk, nb = item % nblk, k0 = 64 * kb, n0 = 32 * nb;
    const int nn = n0 + (lane & 31);
    const int e = mapkind == 0 ? nn : (mapkind == 1 ? colmap1(nn) : 4624 + nn);
#pragma unroll 8
    for (int i = 0; i < 32; ++i) { const int kk = 2 * i + (lane >> 5); scr[kk * 33 + (lane & 31)] = e >= 0 ? W[(size_t)(k0 + kk) * Nsrc + e] : 0.f; }
    asm volatile("s_waitcnt lgkmcnt(0)" ::: "memory");
    const int c = lane & 7;
#pragma unroll
    for (int j = 0; j < 4; ++j) { const int n = (lane >> 3) + 8 * j; const LAS float* s = scr + (8 * c) * 33 + n;
        u32x4 o; o.x = pk2(s[0 * 33], s[1 * 33]); o.y = pk2(s[2 * 33], s[3 * 33]); o.z = pk2(s[4 * 33], s[5 * 33]); o.w = pk2(s[6 * 33], s[7 * 33]);
        *(u32x4*)(WT + (size_t)(n0 + n) * K + k0 + 8 * c) = o; }
    asm volatile("s_waitcnt lgkmcnt(0)" ::: "memory");
}
DI void transpose_seg(const float* W, int Nsrc, int K, bf16_t* WT, int Ndst, int mapkind, LAS float* scr, int gw, int NGW, int lane) {
    const int nblk = Ndst / 32, nitems = (K / 64) * nblk;
    for (int it = gw; it < nitems; it += NGW) transpose_item(W, Nsrc, K, WT, nblk, mapkind, scr, it, lane);
}

DI void gemv9_item(const LAS float* in_s, LAS float* red, const float* W, int ldw, int mapkind, const float* bias, float* out, int ldo, int n0) {
    const int t = tid_opaque(), col = t & 63, part = t >> 6;
    const int nn = n0 + col;
    const int e = mapkind == 0 ? nn : (mapkind == 1 ? colmap1(nn) : 4624 + nn);
    float a[9];
#pragma unroll
    for (int j = 0; j < 9; ++j) a[j] = 0.f;
    if (e >= 0) {
        const float* wp = W + (size_t)(part * 128) * ldw + e;
        for (int d = 0; d < 128; d += 4) {
            const float w0 = wp[(size_t)(d + 0) * ldw], w1 = wp[(size_t)(d + 1) * ldw], w2 = wp[(size_t)(d + 2) * ldw], w3 = wp[(size_t)(d + 3) * ldw];
#pragma unroll
            for (int j = 0; j < 9; ++j) { const f32x4 x = *(const LAS f32x4*)(in_s + j * 1024 + part * 128 + d); a[j] += (x[0] * w0 + x[1] * w1) + (x[2] * w2 + x[3] * w3); }
        }
    }
#pragma unroll
    for (int j = 0; j < 9; ++j) red[(part * 9 + j) * 64 + col] = a[j];
    __syncthreads();
    for (int o = t; o < 9 * 64; o += NTHREADS) {
        const int j = o >> 6, c = o & 63;
        const int n2 = n0 + c;
        const int e2 = mapkind == 0 ? n2 : (mapkind == 1 ? colmap1(n2) : 4624 + n2);
        float sm = 0.f;
#pragma unroll
        for (int p = 0; p < 8; ++p) sm += red[(p * 9 + j) * 64 + c];
        if (e2 >= 0 && bias) sm += bias[e2];
        out[(size_t)j * ldo + n2] = (e2 >= 0) ? sm : 0.f;
    }
    __syncthreads();
}

DI void d1_item(const bool dry, LAS unsigned char* lds, int item, bf16_t* QKV, const bf16_t* HALO, const float* BD, const float* convw, float* GB, bf16_t* TQ, const float* alog, const float* dtb) {
    const int t = tid_opaque(), lane = t & 63, wid = __builtin_amdgcn_readfirstlane(t >> 6);
    const int cg_ = item >> 2, h = item & 3;
    const int rowbase = cg_ * 64;
    int cin_seq, nch;
    if (rowbase < MCTX) { cin_seq = cg_ & 3; nch = 4; } else { cin_seq = (cg_ - 64) & 63; nch = 64; }
    LAS bf16_t* Qs = (LAS bf16_t*)lds;
    LAS bf16_t* Ks = Qs + 64 * 136;
    LAS float* KK = (LAS float*)(lds + 2 * 64 * 136 * 2);
    LAS float* As = KK + 64 * 65;
    LAS float* graw = As + 2 * 64 * 68;
    LAS float* braw = graw + 128;
    LAS float* gam = braw + 128;
    LAS float* bet = gam + 128;
    {
        const int c8 = (t & 15) * 8, rg = t >> 4;
#pragma unroll 1
        for (int ten = 0; ten < 3; ++ten) {
            float res[2][8];
            const int col = ten * 512 + h * 128 + c8;
            {
                u32x4 x[4];
#pragma unroll
                for (int rr = 0; rr < 4; ++rr) {
                    const int li = 2 * rg - 1 + rr;
                    if (li < 0) x[rr] = (cin_seq == 0) ? (u32x4){0u, 0u, 0u, 0u} : *(const u32x4*)(HALO + ((size_t)(cg_ - 1) * 2 + 1) * 1536 + col);
                    else if (li > 63) x[rr] = (cin_seq == nch - 1) ? (u32x4){0u, 0u, 0u, 0u} : *(const u32x4*)(HALO + ((size_t)(cg_ + 1) * 2 + 0) * 1536 + col);
                    else x[rr] = *(const u32x4*)(QKV + (size_t)(rowbase + li) * 1536 + col);
                }
                float w[3][8];
#pragma unroll
                for (int j = 0; j < 3; ++j) { const f32x4 a = *(const f32x4*)(convw + j * 1536 + col), b = *(const f32x4*)(convw + j * 1536 + col + 4);
                    w[j][0] = a[0]; w[j][1] = a[1]; w[j][2] = a[2]; w[j][3] = a[3]; w[j][4] = b[0]; w[j][5] = b[1]; w[j][6] = b[2]; w[j][7] = b[3]; }
                float xf[4][8];
#pragma unroll
                for (int rr = 0; rr < 4; ++rr) { xf[rr][0] = bflo(x[rr].x); xf[rr][1] = bfhi(x[rr].x); xf[rr][2] = bflo(x[rr].y); xf[rr][3] = bfhi(x[rr].y);
                    xf[rr][4] = bflo(x[rr].z); xf[rr][5] = bfhi(x[rr].z); xf[rr][6] = bflo(x[rr].w); xf[rr][7] = bfhi(x[rr].w); }
#pragma unroll
                for (int o = 0; o < 2; ++o)
#pragma unroll
                    for (int e = 0; e < 8; ++e) res[o][e] = silu(w[0][e] * xf[o][e] + w[1][e] * xf[o + 1][e] + w[2][e] * xf[o + 2][e]);
            }
            if (ten < 2) {
#pragma unroll
                for (int o = 0; o < 2; ++o) {
                    float s = 0.f;
#pragma unroll
                    for (int e = 0; e < 8; ++e) s += res[o][e] * res[o][e];
                    s += __shfl_xor(s, 1); s += __shfl_xor(s, 2); s += __shfl_xor(s, 4); s += __shfl_xor(s, 8);
                    const float sc = rsqrtf(s + EPS) * (ten == 0 ? 0.08838834764831845f : 1.0f);
#pragma unroll
                    for (int e = 0; e < 8; ++e) res[o][e] *= sc;
                }
            }
            __syncthreads();
#pragma unroll
            for (int o = 0; o < 2; ++o) {
                u32x4 w; w.x = pk2(res[o][0], res[o][1]); w.y = pk2(res[o][2], res[o][3]); w.z = pk2(res[o][4], res[o][5]); w.w = pk2(res[o][6], res[o][7]);
                const int li = 2 * rg + o;
                if (!dry) *(u32x4*)(QKV + (size_t)(rowbase + li) * 1536 + col) = w;
                if (ten == 0) *(LAS u32x4*)(Qs + li * 136 + c8) = w;
                if (ten == 1) *(LAS u32x4*)(Ks + li * 136 + c8) = w;
            }
        }
        if (t < 128) { const int d = t >> 6, i = t & 63; graw[t] = -__expf(alog[d * 4 + h]) * softplus(BD[(size_t)(rowbase + i) * 16 + 8 + d * 4 + h] + dtb[d * 4 + h]); braw[t] = sigm(BD[(size_t)(rowbase + i) * 16 + d * 4 + h]); }
    }
    __syncthreads();
#pragma unroll
    for (int tt = 0; tt < 2; ++tt) {
        const int tile = wid * 2 + tt, mi = tile >> 2, ni = tile & 3;
        f32x4 acc = (f32x4){0.f, 0.f, 0.f, 0.f};
        acc = mma_tile(acc, Ks + mi * 16 * 136, 136, Ks + ni * 16 * 136, 136, 128, lane);
#pragma unroll
        for (int j = 0; j < 4; ++j) KK[(mi * 16 + (lane >> 4) * 4 + j) * 65 + ni * 16 + (lane & 15)] = acc[j];
    }
    if (t < 128) {
        const int d = t >> 6, ip = t & 63, oi = d ? 63 - ip : ip;
        float g = graw[d * 64 + oi];
#pragma unroll
        for (int o = 1; o < 64; o <<= 1) { const float y = __shfl_up(g, o); if (ip >= o) g += y; }
        const float b = braw[d * 64 + oi];
        gam[t] = g; bet[t] = b;
        float* gb = GB + ((size_t)(cg_ * 4 + h) * 2 + d) * 128;
        if (!dry) { gb[ip] = g; gb[64 + ip] = b; }
    }
    __syncthreads();
    for (int e = t; e < 2 * 4096; e += NTHREADS) {
        const int d = e >> 12, ip = (e >> 6) & 63, jp = e & 63;
        float v = 0.f;
        if (ip > jp) { const int oi = d ? 63 - ip : ip, oj = d ? 63 - jp : jp; v = bet[d * 64 + ip] * KK[oi * 65 + oj] * __expf(gam[d * 64 + ip] - gam[d * 64 + jp]); }
        As[(d * 64 + ip) * 68 + jp] = v;
    }
    __syncthreads();
    if (t < 128) {
        const int d = t >> 6, c = t & 63;
        const LAS float* Ad = As + d * 64 * 68;
        float x[64];
#pragma unroll
        for (int i = 0; i < 64; ++i) {
            float s = (i == c) ? 1.f : 0.f;
#pragma unroll
            for (int j4 = 0; j4 < (i + 3) / 4; ++j4) {
                const f32x4 a = *(const LAS f32x4*)(Ad + i * 68 + j4 * 4);
#pragma unroll
                for (int jj = 0; jj < 4; ++jj) { if (j4 * 4 + jj < i) s -= a[jj] * x[j4 * 4 + jj]; }
            }
            x[i] = s;
        }
        bf16_t* tq = TQ + ((size_t)(cg_ * 4 + h) * 2 + d) * 4096;
#pragma unroll
        for (int i = 0; i < 64; ++i) if (!dry) tq[i * 64 + c] = (bf16_t)f2bf(x[i]);
    }
    __syncthreads();
}

DI void sgu_item(const bool dry, LAS unsigned char* lds, int item, const bf16_t* VB, bf16_t* UBZ, const float* gnorm, const float* wsp, const float* bsp) {
    const int t = tid_opaque(), lane = t & 63, wid = __builtin_amdgcn_readfirstlane(t >> 6);
    const int cb = item >> 2, g = item & 3, r0 = cb * 128;
    LAS bf16_t* Ws = (LAS bf16_t*)lds;
    LAS bf16_t* VT = Ws + 128 * 136;
    LAS float* rinv = (LAS float*)(lds + 2 * 128 * 136 * 2);
    {
        const int q = t >> 2, sub = t & 3;
        const bf16_t* vp = VB + (size_t)(r0 + q) * 512 + sub * 128;
        float s = 0.f;
#pragma unroll
        for (int i = 0; i < 16; ++i) { const u32x4 x = *(const u32x4*)(vp + i * 8);
            const float a0 = bflo(x.x), a1 = bfhi(x.x), a2 = bflo(x.y), a3 = bfhi(x.y), a4 = bflo(x.z), a5 = bfhi(x.z), a6 = bflo(x.w), a7 = bfhi(x.w);
            s += (a0 * a0 + a1 * a1) + (a2 * a2 + a3 * a3) + (a4 * a4 + a5 * a5) + (a6 * a6 + a7 * a7); }
        s += __shfl_xor(s, 1); s += __shfl_xor(s, 2);
        if (sub == 0) rinv[q] = rsqrtf(s * (1.0f / 512.0f) + EPS);
        for (int e = t; e < 128 * 32; e += NTHREADS) { const int p = e >> 5, c4 = (e & 31) * 4; const f32x4 w = *(const f32x4*)(wsp + (size_t)g * 16384 + p * 128 + c4);
            u32x2 o; o.x = pk2(w[0], w[1]); o.y = pk2(w[2], w[3]); *(LAS u32x2*)(Ws + p * 136 + c4) = o; }
    }
    __syncthreads();
    {
        const int q = t >> 2, sub = t & 3;
        const float ri = rinv[q];
#pragma unroll
        for (int i = 0; i < 4; ++i) {
            const int c0 = sub * 32 + i * 8;
            const u32x4 x = *(const u32x4*)(VB + (size_t)(r0 + q) * 512 + g * 128 + c0);
            const f32x4 g0 = *(const f32x4*)(gnorm + g * 128 + c0), g1 = *(const f32x4*)(gnorm + g * 128 + c0 + 4);
            const float v[8] = {bflo(x.x) * ri * g0[0], bfhi(x.x) * ri * g0[1], bflo(x.y) * ri * g0[2], bfhi(x.y) * ri * g0[3], bflo(x.z) * ri * g1[0], bfhi(x.z) * ri * g1[1], bflo(x.w) * ri * g1[2], bfhi(x.w) * ri * g1[3]};
#pragma unroll
            for (int e = 0; e < 8; ++e) VT[(c0 + e) * 136 + q] = (bf16_t)f2bf(v[e]);
        }
    }
    __syncthreads();
#pragma unroll 1
    for (int ni = 0; ni < 8; ++ni) {
        f32x4 acc = (f32x4){0.f, 0.f, 0.f, 0.f};
        acc = mma_tile(acc, Ws + wid * 16 * 136, 136, VT + ni * 16 * 136, 136, 128, lane);
        const int c = g * 128 + ni * 16 + (lane & 15);
#pragma unroll
        for (int j = 0; j < 4; ++j) {
            const int p = wid * 16 + (lane >> 4) * 4 + j;
            bf16_t* up = UBZ + (size_t)(r0 + p) * 512 + c;
            const float o = bf2f(*up) * (acc[j] + bsp[g * 128 + p]);
            if (!dry) *up = (bf16_t)f2bf(o);
        }
    }
    __syncthreads();
}

DI void f1_load_tables(LAS unsigned char* lds, const bf16_t* tab) {
    LAS bf16_t* Fs = (LAS bf16_t*)lds;
    LAS bf16_t* M2s = Fs + 256 * 136;
    const bf16_t* FCH = tab + TAB_FCH / 2; const bf16_t* M2 = tab + TAB_M2 / 2;
    const int t0_ = tid_opaque();
    for (int e = t0_; e < 256 * 16; e += NTHREADS) { const int r = e >> 4, c8 = (e & 15) * 8; *(LAS u32x4*)(Fs + r * 136 + c8) = *(const u32x4*)(FCH + r * 128 + c8); }
    for (int e = t0_; e < 128 * 16; e += NTHREADS) { const int r = e >> 4, c8 = (e & 15) * 8; *(LAS u32x4*)(M2s + r * 136 + c8) = *(const u32x4*)(M2 + r * 128 + c8); }
    __syncthreads();
}
DI void f1_item(const bool dry, LAS unsigned char* lds, int item, bf16_t* XC, bf16_t* IM) {
    const int t = tid_opaque(), lane = t & 63, wid = __builtin_amdgcn_readfirstlane(t >> 6), r = lane & 15, q = lane >> 4;
    LAS bf16_t* Fs = (LAS bf16_t*)lds;
    LAS bf16_t* M2s = Fs + 256 * 136;
    LAS bf16_t* Z1T = M2s + 128 * 136;
    const bool latent = item < 2048;
    int row0, g;
    if (latent) { const int s = item >> 8, rr = (item >> 2) & 63; g = item & 3; row0 = MCTX + s * 4096 + rr * 64; }
    else { const int it = item - 2048; const int s = it >> 4, tb = (it >> 2) & 3; g = it & 3; row0 = s * 256 + tb * 64; }
    bf16x8 xf[4][4];
#pragma unroll
    for (int mt = 0; mt < 4; ++mt)
#pragma unroll
        for (int ks = 0; ks < 4; ++ks) xf[mt][ks] = *(const bf16x8*)(XC + (size_t)(row0 + mt * 16 + r) * 512 + g * 128 + ks * 32 + q * 8);
    __syncthreads();
    if (latent) {
#pragma unroll
        for (int nn = 0; nn < 2; ++nn) {
            const int nt_ = wid * 2 + nn;
            bf16x8 bfr[4];
#pragma unroll
            for (int ks = 0; ks < 4; ++ks) bfr[ks] = *(const LAS bf16x8*)(Fs + (nt_ * 16 + r) * 136 + ks * 32 + q * 8);
#pragma unroll
            for (int mt = 0; mt < 4; ++mt) {
                f32x4 acc = (f32x4){0.f, 0.f, 0.f, 0.f};
#pragma unroll
                for (int ks = 0; ks < 4; ++ks) acc = mfma16(xf[mt][ks], bfr[ks], acc);
                u32x2 w; w.x = pk2(acc[0], acc[1]); w.y = pk2(acc[2], acc[3]);
                *(LAS u32x2*)(Z1T + (nt_ * 16 + r) * 72 + mt * 16 + q * 4) = w;
            }
        }
        __syncthreads();
        bf16x8 af[4];
#pragma unroll
        for (int ks = 0; ks < 4; ++ks) { const int nrow = (ks < 2 ? 0 : 128) + wid * 16 + r; af[ks] = *(const LAS bf16x8*)(Z1T + nrow * 72 + (ks & 1) * 32 + q * 8); }
#pragma unroll 1
        for (int ct = 0; ct < 8; ++ct) {
            f32x4 acc = (f32x4){0.f, 0.f, 0.f, 0.f};
#pragma unroll
            for (int ks = 0; ks < 4; ++ks) { const bf16x8 b = *(const LAS bf16x8*)(M2s + (ct * 16 + r) * 136 + ks * 32 + q * 8); acc = mfma16(af[ks], b, acc); }
            const int c2p = ct * 16 + r;
            bf16_t* dst = (c2p < 64) ? XC : IM;
            u32x2 w; w.x = pk2(acc[0], acc[1]); w.y = pk2(acc[2], acc[3]);
            if (!dry) *(u32x2*)(dst + (size_t)(row0 + (c2p & 63)) * 512 + g * 128 + wid * 16 + q * 4) = w;
        }
    } else {
#pragma unroll
        for (int nn = 0; nn < 2; ++nn) {
            const int nt_ = wid * 2 + nn;
            bf16x8 afr[4];
#pragma unroll
            for (int ks = 0; ks < 4; ++ks) afr[ks] = *(const LAS bf16x8*)(Fs + (nt_ * 16 + r) * 136 + ks * 32 + q * 8);
#pragma unroll
            for (int mt = 0; mt < 4; ++mt) {
                f32x4 acc = (f32x4){0.f, 0.f, 0.f, 0.f};
#pragma unroll
                for (int ks = 0; ks < 4; ++ks) acc = mfma16(afr[ks], xf[mt][ks], acc);
                const int n = nt_ * 16 + q * 4;
                bf16_t* dst = (n < 128) ? XC : IM;
                u32x2 w; w.x = pk2(acc[0], acc[1]); w.y = pk2(acc[2], acc[3]);
                if (!dry) *(u32x2*)(dst + (size_t)(row0 + mt * 16 + r) * 512 + g * 128 + (n & 127)) = w;
            }
        }
    }
    __syncthreads();
}

DI void f3_latent_item(const bool dry, LAS unsigned char* lds, int item, bf16_t* XC, const bf16_t* IM, const bf16_t* ZC) {
    const int t = tid_opaque(), lane = t & 63, wid = __builtin_amdgcn_readfirstlane(t >> 6), r = lane & 15, q = lane >> 4;
    LAS bf16_t* CSs = (LAS bf16_t*)lds;
    LAS bf16_t* ZT = CSs + 64 * 136;
    const int s = item >> 8, g = (item >> 6) & 3, c2 = item & 63;
    const int tok0 = MCTX + s * 4096 + c2;
#pragma unroll
    for (int i = 0; i < 4; ++i) {
        const int e = t + i * NTHREADS, kk = e >> 4, c8 = (e & 15) * 8;
        const bf16_t* src = (kk < 64 ? XC : IM) + (size_t)(tok0 + (kk & 63) * 64) * 512 + g * 128 + c8;
        const u32x4 x = *(const u32x4*)src;
        const unsigned v[4] = {x.x, x.y, x.z, x.w};
#pragma unroll
        for (int p = 0; p < 4; ++p) { ZT[(c8 + 2 * p) * 136 + kk] = (bf16_t)(v[p] & 0xffffu); ZT[(c8 + 2 * p + 1) * 136 + kk] = (bf16_t)(v[p] >> 16); }
    }
    __syncthreads();
    const float nrm = 0.0013810679320049757f;
#pragma unroll 1
    for (int rt = 0; rt < 4; ++rt) {
        f32x4 acc = (f32x4){0.f, 0.f, 0.f, 0.f};
        acc = mma_tile(acc, ZT + wid * 16 * 136, 136, CSs + rt * 16 * 136, 136, 128, lane);
        const size_t off = (size_t)(tok0 + (rt * 16 + r) * 64) * 512 + g * 128 + wid * 16 + q * 4;
        const u32x2 z = *(const u32x2*)(ZC + off);
        u32x2 w; w.x = pk2(acc[0] * nrm * bflo(z.x), acc[1] * nrm * bfhi(z.x)); w.y = pk2(acc[2] * nrm * bflo(z.y), acc[3] * nrm * bfhi(z.y));
        if (!dry) *(u32x2*)(XC + off) = w;
    }
    __syncthreads();
}
DI void f3_context_item(const bool dry, LAS unsigned char* lds, int item, bf16_t* XC, const bf16_t* IM, const bf16_t* ZC, const bf16_t* CS256, bf16_t* OUT) {
    const int t = tid_opaque(), lane = t & 63, wid = __builtin_amdgcn_readfirstlane(t >> 6), r = lane & 15, q = lane >> 4;
    LAS bf16_t* ZT = (LAS bf16_t*)lds;
    const int s = item >> 4, g = (item >> 2) & 3, qt = item & 3, tok0 = s * 256;
    const int tt = qt * 4 + (wid >> 1), m0 = (wid & 1) * 4;
    bf16x8 bfr[16];
#pragma unroll
    for (int ks = 0; ks < 16; ++ks) bfr[ks] = *(const bf16x8*)(CS256 + (size_t)(tt * 16 + r) * 512 + ks * 32 + q * 8);
    for (int e = t; e < 512 * 16; e += NTHREADS) {
        const int kk = e >> 4, c8 = (e & 15) * 8;
        const bf16_t* src = (kk < 256 ? XC : IM) + (size_t)(tok0 + (kk & 255)) * 512 + g * 128 + c8;
        const u32x4 x = *(const u32x4*)src;
        const unsigned v[4] = {x.x, x.y, x.z, x.w};
#pragma unroll
        for (int p = 0; p < 4; ++p) { ZT[(c8 + 2 * p) * 520 + kk] = (bf16_t)(v[p] & 0xffffu); ZT[(c8 + 2 * p + 1) * 520 + kk] = (bf16_t)(v[p] >> 16); }
    }
    __syncthreads();
    const float nrm = 0.005524271728019903f;
    f32x4 acc[4];
#pragma unroll
    for (int m = 0; m < 4; ++m) acc[m] = (f32x4){0.f, 0.f, 0.f, 0.f};
#pragma unroll
    for (int ks = 0; ks < 16; ++ks) {
#pragma unroll
        for (int m = 0; m < 4; ++m) { const bf16x8 a = *(const LAS bf16x8*)(ZT + ((m0 + m) * 16 + r) * 520 + ks * 32 + q * 8); acc[m] = mfma16(a, bfr[ks], acc[m]); }
    }
#pragma unroll
    for (int m = 0; m < 4; ++m) {
        const size_t off = (size_t)(tok0 + tt * 16 + r) * 512 + g * 128 + (m0 + m) * 16 + q * 4;
        const u32x2 z = *(const u32x2*)(ZC + off);
        u32x2 w; w.x = pk2(acc[m][0] * nrm * bflo(z.x), acc[m][1] * nrm * bfhi(z.x)); w.y = pk2(acc[m][2] * nrm * bflo(z.y), acc[m][3] * nrm * bfhi(z.y));
        if (!dry) *(u32x2*)(OUT + off) = w;
    }
    __syncthreads();
}

#define LBAR do { asm volatile("s_waitcnt lgkmcnt(0)" ::: "memory"); __builtin_amdgcn_s_barrier(); asm volatile("" ::: "memory"); } while (0)
DI void chain_item(LAS unsigned char* lds, int item, int layer, const bf16_t* QKV, const bf16_t* TQ, const float* GB, bf16_t* OF, bf16_t* OB, const float* state_in, float* state_out) {
    const int t = tid_opaque(), lane = t & 63, wid = __builtin_amdgcn_readfirstlane(t >> 6), r = lane & 15, q = lane >> 4;
    LAS bf16_t* KS = (LAS bf16_t*)lds;
    LAS bf16_t* QS = KS + 64 * 136;
    LAS bf16_t* KT = QS + 64 * 136;
    LAS bf16_t* TS = KT + 128 * 72;
    LAS bf16_t* QKM = TS + 64 * 72;
    LAS bf16_t* ST = QKM + 64 * 72;
    LAS bf16_t* XT = ST + 2 * 32 * 136;
    LAS bf16_t* UT = XT + 32 * 72;
    LAS bf16_t* UDT = UT + 32 * 72;
    LAS float* VBs = (LAS float*)(UDT + 32 * 72);
    LAS float* gam = VBs + 64 * 36;
    LAS float* bet = gam + 64;
    int rs, nch, sidx; bool latent = item < 256;
    const int ii = latent ? item : item - 256;
    const int h = (ii >> 3) & 3, d = (ii >> 2) & 1, vs = ii & 3; sidx = ii >> 5;
    if (latent) { rs = MCTX + sidx * 4096; nch = 64; } else { rs = sidx * 256; nch = 4; }
    bf16_t* O = d ? OB : OF;
    f32x4 sacc[2];
#pragma unroll
    for (int ni = 0; ni < 2; ++ni) {
        if (latent) {
            const float* sp = state_in + ((((size_t)sidx * NLAYER + layer) * 2 + d) * 4 + h) * 16384;
#pragma unroll
            for (int j = 0; j < 4; ++j) sacc[ni][j] = sp[(size_t)(wid * 16 + q * 4 + j) * 128 + vs * 32 + ni * 16 + r];
        } else sacc[ni] = (f32x4){0.f, 0.f, 0.f, 0.f};
        u32x2 w; w.x = pk2(sacc[ni][0], sacc[ni][1]); w.y = pk2(sacc[ni][2], sacc[ni][3]);
        *(LAS u32x2*)(ST + (ni * 16 + r) * 136 + wid * 16 + q * 4) = w;
    }
    const int ki = t >> 3, kseg = (t & 7) * 16;
    const int vi = (t >> 2) & 63, vseg = (t & 3) * 8;
    u32x4 kreg[2], qreg[2], vreg, treg; float gv = 0.f, bv = 0.f, bvv = 0.f;
#define CH_PREFETCH(n) do { const int c_ = d ? nch - 1 - (n) : (n); const int cgl = (rs >> 6) + c_; \
        const size_t orow = (size_t)rs + c_ * 64 + (d ? 63 - ki : ki); \
        kreg[0] = *(const u32x4*)(QKV + orow * 1536 + 512 + h * 128 + kseg); kreg[1] = *(const u32x4*)(QKV + orow * 1536 + 512 + h * 128 + kseg + 8); \
        qreg[0] = *(const u32x4*)(QKV + orow * 1536 + h * 128 + kseg); qreg[1] = *(const u32x4*)(QKV + orow * 1536 + h * 128 + kseg + 8); \
        const size_t base_ = (size_t)(cgl * 4 + h) * 2 + d; \
        treg = *(const u32x4*)(TQ + base_ * 4096 + (size_t)ki * 64 + (t & 7) * 8); \
        if (t < 256) { const size_t vrow = (size_t)rs + c_ * 64 + (d ? 63 - vi : vi); vreg = *(const u32x4*)(QKV + vrow * 1536 + 1024 + h * 128 + vs * 32 + vseg); bvv = GB[base_ * 128 + 64 + vi]; } \
        if (t < 64) { gv = GB[base_ * 128 + t]; bv = GB[base_ * 128 + 64 + t]; } } while (0)
    CH_PREFETCH(0);
    for (int n = 0; n < nch; ++n) {
        const int cur = n & 1;
        LAS bf16_t* STc = ST + cur * 32 * 136; LAS bf16_t* STn = ST + (cur ^ 1) * 32 * 136;
        *(LAS u32x4*)(KS + ki * 136 + kseg) = kreg[0]; *(LAS u32x4*)(KS + ki * 136 + kseg + 8) = kreg[1];
        *(LAS u32x4*)(QS + ki * 136 + kseg) = qreg[0]; *(LAS u32x4*)(QS + ki * 136 + kseg + 8) = qreg[1];
        {
            const unsigned kv[8] = {kreg[0].x, kreg[0].y, kreg[0].z, kreg[0].w, kreg[1].x, kreg[1].y, kreg[1].z, kreg[1].w};
#pragma unroll
            for (int p = 0; p < 8; ++p) { KT[(kseg + 2 * p) * 72 + ki] = (bf16_t)(kv[p] & 0xffffu); KT[(kseg + 2 * p + 1) * 72 + ki] = (bf16_t)(kv[p] >> 16); }
        }
        {
            const int i = ki, j0 = (t & 7) * 8;
            unsigned tv[4] = {treg.x, treg.y, treg.z, treg.w};
#pragma unroll
            for (int p = 0; p < 4; ++p) {
                const int ja = j0 + 2 * p, jb = ja + 1;
                unsigned lo = tv[p] & 0xffffu, hi = tv[p] >> 16;
                if (ja >= i) lo = (ja == i) ? 0x3f80u : 0u;
                if (jb >= i) hi = (jb == i) ? 0x3f80u : 0u;
                tv[p] = lo | (hi << 16);
            }
            *(LAS u32x4*)(TS + i * 72 + j0) = (u32x4){tv[0], tv[1], tv[2], tv[3]};
        }
        if (t < 256) {
            const float vv[8] = {bflo(vreg.x), bfhi(vreg.x), bflo(vreg.y), bfhi(vreg.y), bflo(vreg.z), bfhi(vreg.z), bflo(vreg.w), bfhi(vreg.w)};
            *(LAS f32x4*)(VBs + vi * 36 + vseg) = (f32x4){vv[0] * bvv, vv[1] * bvv, vv[2] * bvv, vv[3] * bvv};
            *(LAS f32x4*)(VBs + vi * 36 + vseg + 4) = (f32x4){vv[4] * bvv, vv[5] * bvv, vv[6] * bvv, vv[7] * bvv};
        }
        if (t < 64) { gam[t] = gv; bet[t] = bv; }
        LBAR;
        if (n + 1 < nch) CH_PREFETCH(n + 1);
        const float glast = gam[63];
#pragma unroll
        for (int tt = 0; tt < 2; ++tt) {
            const int tile = wid * 2 + tt, mi = tile >> 2, ni = tile & 3;
            f32x4 acc = (f32x4){0.f, 0.f, 0.f, 0.f};
            if (ni <= mi) acc = mma_tile(acc, QS + mi * 16 * 136, 136, KS + ni * 16 * 136, 136, 128, lane);
            const int jj = ni * 16 + r; const float gj = gam[jj];
#pragma unroll
            for (int j = 0; j < 4; ++j) { const int i = mi * 16 + q * 4 + j; const float v = (i >= jj) ? acc[j] * __expf(gam[i] - gj) : 0.f; QKM[i * 72 + jj] = (bf16_t)f2bf(v); }
        }
        const int mi = wid >> 1, ni = wid & 1;
        {
            f32x4 acc = (f32x4){0.f, 0.f, 0.f, 0.f};
            acc = mma_tile(acc, KS + mi * 16 * 136, 136, STc + ni * 16 * 136, 136, 128, lane);
            float x[4];
#pragma unroll
            for (int j = 0; j < 4; ++j) { const int i = mi * 16 + q * 4 + j; x[j] = VBs[i * 36 + ni * 16 + r] - bet[i] * __expf(gam[i]) * acc[j]; }
            u32x2 w; w.x = pk2(x[0], x[1]); w.y = pk2(x[2], x[3]);
            *(LAS u32x2*)(XT + (ni * 16 + r) * 72 + mi * 16 + q * 4) = w;
        }
        LBAR;
        {
            f32x4 acc = (f32x4){0.f, 0.f, 0.f, 0.f};
            acc = mma_tile(acc, TS + mi * 16 * 72, 72, XT + ni * 16 * 72, 72, 64, lane);
            float ud[4];
#pragma unroll
            for (int j = 0; j < 4; ++j) { const int i = mi * 16 + q * 4 + j; ud[j] = acc[j] * __expf(glast - gam[i]); }
            u32x2 w; w.x = pk2(acc[0], acc[1]); w.y = pk2(acc[2], acc[3]);
            *(LAS u32x2*)(UT + (ni * 16 + r) * 72 + mi * 16 + q * 4) = w;
            u32x2 w2; w2.x = pk2(ud[0], ud[1]); w2.y = pk2(ud[2], ud[3]);
            *(LAS u32x2*)(UDT + (ni * 16 + r) * 72 + mi * 16 + q * 4) = w2;
        }
        LBAR;
        {
            f32x4 acc = (f32x4){0.f, 0.f, 0.f, 0.f};
            acc = mma_tile(acc, QS + mi * 16 * 136, 136, STc + ni * 16 * 136, 136, 128, lane);
#pragma unroll
            for (int j = 0; j < 4; ++j) acc[j] *= __expf(gam[mi * 16 + q * 4 + j]);
            acc = mma_tile(acc, QKM + mi * 16 * 72, 72, UT + ni * 16 * 72, 72, 64, lane);
            const int c_ = d ? nch - 1 - n : n;
#pragma unroll
            for (int j = 0; j < 4; ++j) { const int i = mi * 16 + q * 4 + j; const size_t orow = (size_t)rs + c_ * 64 + (d ? 63 - i : i);
                O[orow * 512 + h * 128 + vs * 32 + ni * 16 + r] = (bf16_t)f2bf(acc[j]); }
        }
        {
            const float gl = __expf(glast);
#pragma unroll
            for (int n2 = 0; n2 < 2; ++n2) {
                sacc[n2] = sacc[n2] * gl;
                sacc[n2] = mma_tile(sacc[n2], KT + wid * 16 * 72, 72, UDT + n2 * 16 * 72, 72, 64, lane);
                u32x2 w; w.x = pk2(sacc[n2][0], sacc[n2][1]); w.y = pk2(sacc[n2][2], sacc[n2][3]);
                *(LAS u32x2*)(STn + (n2 * 16 + r) * 136 + wid * 16 + q * 4) = w;
            }
        }
        LBAR;
    }
#undef CH_PREFETCH
    if (!latent) {
        float* sp = state_out + ((((size_t)sidx * NLAYER + layer) * 2 + d) * 4 + h) * 16384;
#pragma unroll
        for (int n2 = 0; n2 < 2; ++n2)
#pragma unroll
            for (int j = 0; j < 4; ++j) sp[(size_t)(wid * 16 + q * 4 + j) * 128 + vs * 32 + n2 * 16 + r] = sacc[n2][j];
    }
}

__global__ void __launch_bounds__(NTHREADS) mega_fwd(Params P) {
    extern __shared__ __attribute__((aligned(16))) unsigned char lds_raw[];
    LAS unsigned char* lds = (LAS unsigned char*)lds_raw;
    cg::grid_group grid = cg::this_grid();
    const int G = gridDim.x, bx = blockIdx.x, NGW = G * 8;
    const int xcc = (int)(__builtin_amdgcn_s_getreg((3 << 11) | 20) & 0xFu);
    int myrank = 0, cvirt = bx;
    bool fastbar = false;
#pragma unroll 1
    for (int step0 = -2 * DUP_P0; step0 < 27; ++step0) {
        const int step = step0 < 0 ? step0 + 2 : step0;
        const int kind = step < 2 ? step : (step == 26 ? 8 : 2 + (step - 2) % 6);
        const int l = step < 2 ? 0 : (step == 26 ? 3 : (step - 2) / 6);
        const int t = tid_opaque(), lane = t & 63, wid = __builtin_amdgcn_readfirstlane(t >> 6), gw = bx * 8 + wid;
        unsigned char* ws = P.ws;
        float* out = P.out;
        bf16_t* HS = (bf16_t*)(ws + ((l & 1) ? OFF_Y : OFF_X));
        bf16_t* OTH = (bf16_t*)(ws + ((l & 1) ? OFF_X : OFF_Y));
        if (kind == 0) {
            const float* c_ctx = P.in[4]; const float* cvec = P.in[3];
            LAS float* in_s = (LAS float*)lds; LAS float* red = in_s + 9 * 1024;
            for (int e = t; e < 9 * 1024; e += NTHREADS) { const int j = e >> 10, dd = e & 1023; const float c = (j == 0) ? c_ctx[dd] : cvec[(j - 1) * 1024 + dd]; in_s[e] = silu(c); }
            __syncthreads();
            for (int it = bx; it < 4 * 48; it += G) { const int ll = it / 48, nb = it % 48;
                gemv9_item(in_s, red, P.in[6] + (size_t)ll * 1024 * 3072, 3072, 0, P.in[7] + ll * 3072, (float*)(ws + OFF_MOD) + (size_t)ll * 9 * 3072, 3072, nb * 64); }
            __syncthreads();
            float* ROWSQ = (float*)(ws + OFF_ROWSQ);
            if (bx == 0) { ((unsigned*)(ws + OFF_CTR))[t] = 0u; ((unsigned*)(ws + OFF_CTR))[t + 512] = 0u; }
            for (int e = bx * NTHREADS + t; e < 5 * MTOT; e += G * NTHREADS) ROWSQ[e] = 0.f;
            bf16_t* TAB = (bf16_t*)(ws + OFF_TAB);
            for (int e = bx * NTHREADS + t; e < 188416; e += G * NTHREADS) {
                float v;
                if (e < 32768) { const int n = e >> 7, ch = e & 127; const int m = ((n & 127) * ch) & 127; v = (n < 128) ? cospif(m * (2.0f / 128.0f)) : -sinpif(m * (2.0f / 128.0f)); }
                else if (e < 49152) { const int i = e - 32768, rr = i >> 7, kk = i & 127; const int m = ((rr & 63) * (kk & 63)) & 63; const float c = cospif(m * (2.0f / 64.0f)), sn = sinpif(m * (2.0f / 64.0f));
                    v = (rr < 64) ? (kk < 64 ? c : sn) : (kk < 64 ? -sn : c); }
                else if (e < 57344) { const int i = e - 49152, rr = i >> 7, kk = i & 127; const int m = (rr * (kk & 63)) & 63; v = (kk < 64) ? cospif(m * (2.0f / 64.0f)) : sinpif(m * (2.0f / 64.0f)); }
                else { const int i = e - 57344, rr = i >> 9, kk = i & 511; const int m = (rr * (kk & 255)) & 255; v = (kk < 256) ? cospif(m * (2.0f / 256.0f)) : sinpif(m * (2.0f / 256.0f)); }
                TAB[e] = (bf16_t)f2bf(v);
            }
            __syncthreads();
            transpose_seg(P.in[8], NIN, 1024, (bf16_t*)(ws + OFF_W1), N1, 1, (LAS float*)(lds + wid * 16384), gw, NGW, lane);
        } else if (kind == 1) {
            const float* w_in = P.in[8];
            float* MOD = (float*)(ws + OFF_MOD);
            {
                volatile LAS unsigned* rk = (volatile LAS unsigned*)(lds + 140000);
                if (t == 0) rk[0] = atomicAdd((unsigned*)(ws + OFF_CTR) + xcc, 1u);
                __syncthreads();
                myrank = __builtin_amdgcn_readfirstlane((int)rk[0]);
            }
            LAS float* in_s = (LAS float*)lds; LAS float* red = in_s + 9 * 1024;
            for (int it = bx; it < 4 * 124; it += G) {
                const int ll = it / 124, nb = it % 124;
                __syncthreads();
                for (int e = t; e < 9 * 1024; e += NTHREADS) { const int j = e >> 10, dd = e & 1023; in_s[e] = MOD[((size_t)ll * 9 + j) * 3072 + dd]; }
                __syncthreads();
                if (nb < 76) gemv9_item(in_s, red, w_in + (size_t)ll * 1024 * NIN, NIN, 1, nullptr, (float*)(ws + OFF_SW1) + (size_t)ll * 9 * N1, N1, nb * 64);
                else gemv9_item(in_s, red, w_in + (size_t)ll * 1024 * NIN, NIN, 2, nullptr, (float*)(ws + OFF_SWG) + (size_t)ll * 9 * NGATE, NGATE, (nb - 76) * 64);
            }
            bf16_t* HS0 = (bf16_t*)(ws + OFF_X);
            float* ROWSQ = (float*)(ws + OFF_ROWSQ);
            const float* x_prompt = P.in[0]; const float* x_sample = P.in[1]; const float* ln_g = P.in[5];
            for (int row = gw; row < MTOT; row += NGW) {
                const float* xr = row < MCTX ? x_prompt + (size_t)row * DM : x_sample + (size_t)(row - MCTX) * DM;
                const int bidx = bidx_of_row(row);
                f32x4 v[4]; float sq = 0.f;
#pragma unroll
                for (int j = 0; j < 4; ++j) { v[j] = *(const f32x4*)(xr + j * 256 + lane * 4); sq += (v[j][0] * v[j][0] + v[j][1] * v[j][1]) + (v[j][2] * v[j][2] + v[j][3] * v[j][3]); }
#pragma unroll
                for (int o = 1; o < 64; o <<= 1) sq += __shfl_xor(sq, o);
                if (lane == 0) ROWSQ[row] = sq;
#pragma unroll
                for (int j = 0; j < 4; ++j) { const int col = j * 256 + lane * 4;
                    const f32x4 lg = *(const f32x4*)(ln_g + col); const f32x4 sc = *(const f32x4*)(MOD + (size_t)bidx * 3072 + 1024 + col);
                    const f32x4 y = v[j] * lg * (sc + 1.0f); u32x2 w; w.x = pk2(y[0], y[1]); w.y = pk2(y[2], y[3]); *(u32x2*)(HS0 + (size_t)row * DM + col) = w; }
            }
        } else if (kind == 3) {
            LAS float* scr = (LAS float*)(lds + wid * 16384);
            const float* w_in = P.in[8];
            if (l + 1 < NLAYER) transpose_seg(w_in + (size_t)(l + 1) * 1024 * NIN, NIN, 1024, (bf16_t*)(ws + OFF_W1), N1, 1, scr, gw, NGW, lane);
            transpose_seg(w_in + (size_t)l * 1024 * NIN, NIN, 1024, (bf16_t*)(ws + OFF_WG), NGATE, 2, scr, gw, NGW, lane);
            for (int b = 0; b < 3; ++b) transpose_seg(P.in[16] + ((size_t)l * 3 + b) * 512 * 1024, 1024, 512, (bf16_t*)(ws + OFF_WBR) + (size_t)b * 1024 * 512, 1024, 0, scr, gw, NGW, lane);
            transpose_seg(P.in[17] + (size_t)l * 1024 * 1024, 1024, 1024, (bf16_t*)(ws + OFF_WOUT), 1024, 0, scr, gw, NGW, lane);
            __syncthreads();
            const bool dryrt = (P.out != nullptr);
            for (int rep = (DUP_BI ? 0 : 1); rep < 2; ++rep) {
                const bool dry = (rep == 0) && dryrt;
                for (int it = bx; it < 2304; it += G) d1_item(dry, lds, it, (bf16_t*)(ws + OFF_QKV), (const bf16_t*)(ws + OFF_HALO), (const float*)(ws + OFF_BD), P.in[9] + (size_t)l * 3 * 1536, (float*)(ws + OFF_GB), (bf16_t*)(ws + OFF_TQ), P.in[10] + l * 8, P.in[11] + l * 8);
                for (int it = bx; it < 1152; it += G) sgu_item(dry, lds, it, OTH, (bf16_t*)(ws + OFF_UBZ), P.in[13] + l * 512, P.in[14] + (size_t)l * 4 * 16384, P.in[15] + l * 512);
                f1_load_tables(lds, (const bf16_t*)(ws + OFF_TAB));
                for (int it = bx; it < 2304; it += G) f1_item(dry, lds, it, (bf16_t*)(ws + OFF_XC), (bf16_t*)(ws + OFF_IM));
            }
        } else if (kind == 4) {
            bf16_t* OF = OTH; bf16_t* OB = OTH + (size_t)MTOT * 512;
            for (int rep = 0; rep < (DUP_CHAIN ? 2 : 1); ++rep)
            for (int it = bx; it < 768; it += G) { chain_item(lds, it, l, (const bf16_t*)(ws + OFF_QKV), (const bf16_t*)(ws + OFF_TQ), (const float*)(ws + OFF_GB), OF, OB, P.in[2], out + (size_t)MTOT * DM); __syncthreads(); }
            {
                LAS bf16_t* CSs = (LAS bf16_t*)lds; const bf16_t* CS64 = (const bf16_t*)(ws + OFF_TAB) + TAB_CS64 / 2;
                for (int e = t; e < 64 * 16; e += NTHREADS) { const int rr = e >> 4, c8 = (e & 15) * 8; *(LAS u32x4*)(CSs + rr * 136 + c8) = *(const u32x4*)(CS64 + rr * 128 + c8); }
                __syncthreads();
            }
            const bool dryrt = (P.out != nullptr);
            for (int rep = (DUP_F3 ? 0 : 1); rep < 2; ++rep) {
                const bool dry = (rep == 0) && dryrt;
                for (int it = bx; it < 2048; it += G) f3_latent_item(dry, lds, it, (bf16_t*)(ws + OFF_XC), (const bf16_t*)(ws + OFF_IM), (const bf16_t*)(ws + OFF_ZC));
                for (int it = bx; it < 256; it += G) f3_context_item(dry, lds, it, (bf16_t*)(ws + OFF_XC), (const bf16_t*)(ws + OFF_IM), (const bf16_t*)(ws + OFF_ZC), (const bf16_t*)(ws + OFF_TAB) + TAB_CS256 / 2, (bf16_t*)(ws + OFF_SPARE));
            }
        } else if (kind == 8) {
            const float* rowsq = (const float*)(ws + OFF_ROWSQ) + (size_t)4 * MTOT; const float* final_g = P.in[18];
            for (int row = gw; row < MTOT; row += NGW) {
                const float ri = rsqrtf(rowsq[row] * (1.0f / DM) + EPS);
#pragma unroll
                for (int j = 0; j < 4; ++j) { const int col = j * 256 + lane * 4; float* p = out + (size_t)row * DM + col;
                    const f32x4 v = *(const f32x4*)p; const f32x4 g = *(const f32x4*)(final_g + col); *(f32x4*)p = v * ri * g; }
            }
        } else {
            if (kind == 5) {
                const bf16_t* OF = OTH; const bf16_t* OB = OTH + (size_t)MTOT * 512; bf16_t* ZA = (bf16_t*)(ws + OFF_ZA);
                const float* og = P.in[12] + l * 128;
                for (int row = gw; row < MCTX; row += NGW) *(u32x4*)((bf16_t*)(ws + OFF_XC) + (size_t)row * 512 + lane * 8) = *(const u32x4*)((const bf16_t*)(ws + OFF_SPARE) + (size_t)row * 512 + lane * 8);
                for (int row = gw; row < MTOT; row += NGW) {
                    const size_t off = (size_t)row * 512 + lane * 8;
                    const u32x4 a = *(const u32x4*)(OF + off), b = *(const u32x4*)(OB + off), z = *(const u32x4*)(ZA + off);
                    f32x4 o0 = (f32x4){bflo(a.x) + bflo(b.x), bfhi(a.x) + bfhi(b.x), bflo(a.y) + bflo(b.y), bfhi(a.y) + bfhi(b.y)};
                    f32x4 o1 = (f32x4){bflo(a.z) + bflo(b.z), bfhi(a.z) + bfhi(b.z), bflo(a.w) + bflo(b.w), bfhi(a.w) + bfhi(b.w)};
                    float sq = (o0[0] * o0[0] + o0[1] * o0[1]) + (o0[2] * o0[2] + o0[3] * o0[3]) + (o1[0] * o1[0] + o1[1] * o1[1]) + (o1[2] * o1[2] + o1[3] * o1[3]);
                    sq += __shfl_xor(sq, 1); sq += __shfl_xor(sq, 2); sq += __shfl_xor(sq, 4); sq += __shfl_xor(sq, 8);
                    const float ri = rsqrtf(sq * (1.0f / 128.0f) + EPS);
                    const int c0 = (lane & 15) * 8;
                    const f32x4 g0 = *(const f32x4*)(og + c0), g1 = *(const f32x4*)(og + c0 + 4);
                    const f32x4 z0 = (f32x4){bflo(z.x), bfhi(z.x), bflo(z.y), bfhi(z.y)}, z1 = (f32x4){bflo(z.z), bfhi(z.z), bflo(z.w), bfhi(z.w)};
                    o0 = o0 * ri * g0 * z0; o1 = o1 * ri * g1 * z1;
                    u32x4 w; w.x = pk2(o0[0], o0[1]); w.y = pk2(o0[2], o0[3]); w.z = pk2(o1[0], o1[1]); w.w = pk2(o1[2], o1[3]);
                    *(u32x4*)(ZA + off) = w;
                }
                __syncthreads();
            }
            if (step == 2) {
                const unsigned* ctr = (const unsigned*)(ws + OFF_CTR);
                bool ok = (G % 8) == 0 && xcc < 8;
                for (int j = 0; j < 8; ++j) ok = ok && ((int)__hip_atomic_load(ctr + j, __ATOMIC_RELAXED, __HIP_MEMORY_SCOPE_AGENT) == G / 8);
                cvirt = ok ? myrank * 8 + xcc : bx;
                fastbar = ok;
            }
            pg8::Sched S; S.nM = MTOT / 256; S.G = G; S.c = cvirt; S.nsub = 1; S.K = 1024; S.bsub = 0;
            S.A0 = (const char*)HS; S.asub = 0;
            EpiAll E; E.layer = l; E.ws = ws; E.out = out; E.xp = P.in[0]; E.xs = P.in[1];
            E.lng_next = P.in[5] + (size_t)(l + 1 < NLAYER ? l + 1 : l) * DM; E.hs = HS; E.oth = OTH;
            if (kind == 2) { E.mode = 0; S.nN = N1 / 256; S.B0 = (const char*)(ws + OFF_W1); }
            else if (kind == 5) { E.mode = 1; S.nN = NGATE / 256; S.B0 = (const char*)(ws + OFF_WG); }
            else if (kind == 6) { E.mode = 2; S.nN = 4; S.nsub = 3; S.K = 512; S.A0 = (const char*)(ws + OFF_ZA); S.asub = RB;
                S.B0 = (const char*)(ws + OFF_WBR); S.bsub = (size_t)1024 * 512 * 2; }
            else { E.mode = 3; S.nN = 4; S.B0 = (const char*)(ws + OFF_WOUT); }
            S.nwg = S.nM * S.nN;
            S.pre = (kind == 2 || kind == 5);
            S.pre_rq = (const float*)(ws + OFF_ROWSQ) + (size_t)l * MTOT;
            S.pre_sw = (kind == 2) ? (const float*)(ws + OFF_SW1) + (size_t)l * 9 * N1 : (const float*)(ws + OFF_SWG) + (size_t)l * 9 * NGATE;
            S.pre_ld = (kind == 2) ? N1 : NGATE;
            for (int rep = ((DUP_GEMM && kind != 7) ? 0 : 1); rep < 2; ++rep) { E.dry = (rep == 0) && (P.out != nullptr); pg8::gemm_phase<EpiAll>(lds, S, E); __syncthreads(); }
        }
        if (!fastbar) grid.sync();
        else {
            unsigned* ctr = (unsigned*)(P.ws + OFF_CTR);
            asm volatile("s_waitcnt vmcnt(0)" ::: "memory");
            __syncthreads();
            if (threadIdx.x == 0) {
                const unsigned nloc = (unsigned)(G / 8);
                unsigned* xsub = ctr + 128 + 32 * xcc; unsigned* xgen = ctr + 384 + 32 * xcc; unsigned* top = ctr + 640; unsigned* topgen = ctr + 672;
                const unsigned old = __hip_atomic_fetch_add(xsub, 1u, __ATOMIC_RELAXED, __HIP_MEMORY_SCOPE_AGENT);
                const unsigned gen = old / nloc;
                if (old + 1u == (gen + 1u) * nloc) {
                    __builtin_amdgcn_fence(__ATOMIC_RELEASE, "agent");
                    asm volatile("s_waitcnt vmcnt(0)" ::: "memory");
                    const unsigned og = __hip_atomic_fetch_add(top, 1u, __ATOMIC_RELAXED, __HIP_MEMORY_SCOPE_AGENT);
                    const unsigned tg = og / 8u;
                    if (og + 1u == (tg + 1u) * 8u) __hip_atomic_fetch_add(topgen, 1u, __ATOMIC_RELAXED, __HIP_MEMORY_SCOPE_AGENT);
                    else { while (__hip_atomic_load(topgen, __ATOMIC_RELAXED, __HIP_MEMORY_SCOPE_AGENT) == tg) __builtin_amdgcn_s_sleep(1); }
                    __builtin_amdgcn_fence(__ATOMIC_ACQUIRE, "agent");
                    __hip_atomic_fetch_add(xgen, 1u, __ATOMIC_RELAXED, __HIP_MEMORY_SCOPE_AGENT);
                    asm volatile("s_waitcnt vmcnt(0)" ::: "memory");
                } else {
                    while (__hip_atomic_load(xgen, __ATOMIC_RELAXED, __HIP_MEMORY_SCOPE_AGENT) == gen) __builtin_amdgcn_s_sleep(1);
                    __builtin_amdgcn_fence(__ATOMIC_ACQUIRE, "agent");
                    asm volatile("s_waitcnt vmcnt(0)" ::: "memory");
                }
            }
            __syncthreads();
        }
    }
}

extern "C" void kernel_launch(void* const* d_in, const int* in_sizes, int n_in, void* d_out, int out_size, void* d_ws, size_t ws_size, hipStream_t stream) {
    static int grid_blocks = 0;
    if (grid_blocks == 0) {
        if (n_in != 19 || ws_size < WS_END) { fprintf(stderr, "kernel_launch: unexpected inputs (n_in %d, ws %zu, need %zu)\n", n_in, ws_size, (size_t)WS_END); grid_blocks = -1; return; }
        int dev = 0, cus = 0, per_cu = 0;
        hipGetDevice(&dev);
        hipDeviceGetAttribute(&cus, hipDeviceAttributeMultiprocessorCount, dev);
        if (hipFuncSetAttribute((const void*)mega_fwd, hipFuncAttributeMaxDynamicSharedMemorySize, LDS_BYTES) != hipSuccess) { fprintf(stderr, "kernel_launch: hipFuncSetAttribute failed\n"); grid_blocks = -1; return; }
        if (hipOccupancyMaxActiveBlocksPerMultiprocessor(&per_cu, (const void*)mega_fwd, NTHREADS, LDS_BYTES) != hipSuccess || per_cu < 1) { fprintf(stderr, "kernel_launch: occupancy query gave %d\n", per_cu); per_cu = 1; }
        (void)hipGetLastError();
        grid_blocks = cus * per_cu;
    }
    if (grid_blocks < 0) return;
    Params p{};
    for (int i = 0; i < 19; ++i) p.in[i] = (const float*)d_in[i];
    p.out = (float*)d_out; p.ws = (unsigned char*)d_ws;
    void* args[] = {&p};
    hipError_t e = hipLaunchCooperativeKernel((const void*)mega_fwd, dim3(grid_blocks), dim3(NTHREADS), args, LDS_BYTES, stream);
    if (e != hipSuccess) fprintf(stderr, "cooperative launch failed: %s (grid %d)\n", hipGetErrorString(e), grid_blocks);
}
```

```cpp
#include <hip/hip_runtime.h>
#include <hip/hip_cooperative_groups.h>
#include <cstdio>
namespace cg = cooperative_groups;

#define DI __device__ __forceinline__
#define LAS __attribute__((address_space(3)))
typedef unsigned short bf16_t;
typedef short bf16x8 __attribute__((ext_vector_type(8)));
typedef float f32x4 __attribute__((ext_vector_type(4)));
typedef unsigned u32x4 __attribute__((ext_vector_type(4)));
typedef unsigned u32x2 __attribute__((ext_vector_type(2)));

constexpr int DM = 1024, MCTX = 4096, MTOT = 36864, NLAYER = 4;
constexpr int N1 = 4864, NGATE = 3072, NIN = 7696;
constexpr float EPS = 1e-6f;
constexpr int NTHREADS = 512;
constexpr int LDS_BYTES = 147456;
#ifndef DUP_GEMM
#define DUP_GEMM 0
#endif
#ifndef DUP_CHAIN
#define DUP_CHAIN 0
#endif
#ifndef DUP_P0
#define DUP_P0 0
#endif
#ifndef DUP_BI
#define DUP_BI 0
#endif
#ifndef DUP_F3
#define DUP_F3 0
#endif

constexpr size_t RB = (size_t)MTOT * 512 * 2;
constexpr size_t OFF_MOD = 0;
constexpr size_t OFF_SW1 = 524288;
constexpr size_t OFF_SWG = 1310720;
constexpr size_t OFF_ROWSQ = 1835008;
constexpr size_t OFF_CTR = 1830912;
constexpr size_t OFF_BD = 2621440;
constexpr size_t OFF_GB = 5242880;
constexpr size_t OFF_HALO = 7864320;
constexpr size_t OFF_TAB = 11534336;
constexpr size_t TAB_FCH = 0, TAB_M2 = 65536, TAB_CS64 = 98304, TAB_CS256 = 114688;
constexpr size_t OFF_W1 = 12582912;
constexpr size_t OFF_WG = OFF_W1 + (size_t)N1 * 1024 * 2;
constexpr size_t OFF_WBR = OFF_WG + (size_t)NGATE * 1024 * 2;
constexpr size_t OFF_WOUT = OFF_WBR + (size_t)3 * 1024 * 512 * 2;
constexpr size_t OFF_X = OFF_WOUT + (size_t)1024 * 1024 * 2;
constexpr size_t OFF_Y = OFF_X + 2 * RB;
constexpr size_t OFF_G = OFF_Y + 2 * RB;
constexpr size_t OFF_QKV = OFF_G, OFF_TQ = OFF_G + 3 * RB, OFF_IM = OFF_G + 4 * RB, OFF_ZC = OFF_G + 5 * RB;
constexpr size_t OFF_ZA = OFF_G + 6 * RB, OFF_UBZ = OFF_ZA + RB, OFF_XC = OFF_UBZ + RB, OFF_SPARE = OFF_XC + RB, WS_END = OFF_SPARE + (size_t)MCTX * 512 * 2;

struct Params {
    const float* in[19];
    float* out;
    unsigned char* ws;
};

DI unsigned f2bf(float f) { const __bf16 b = (__bf16)f; return (unsigned)__builtin_bit_cast(unsigned short, b); }
typedef float f32x2_t __attribute__((ext_vector_type(2)));
typedef __bf16 bf16x2_t __attribute__((ext_vector_type(2)));
DI unsigned pk2(float lo, float hi) { const f32x2_t v = {lo, hi}; const bf16x2_t b = __builtin_convertvector(v, bf16x2_t); return __builtin_bit_cast(unsigned, b); }
DI float bflo(unsigned u) { return __builtin_bit_cast(float, u << 16); }
DI float bfhi(unsigned u) { return __builtin_bit_cast(float, u & 0xffff0000u); }
DI float bf2f(bf16_t h) { return __builtin_bit_cast(float, ((unsigned)h) << 16); }
DI float sigm(float x) { return __builtin_amdgcn_rcpf(1.0f + __expf(-x)); }
DI float silu(float x) { return x * sigm(x); }
DI float softplus(float x) { return fmaxf(x, 0.f) + log1pf(__expf(-fabsf(x))); }
DI int tid_opaque() { int t = threadIdx.x; asm volatile("" : "+v"(t)); return t; }
constexpr int PTAB_OFF = 147456 - 256;
DI void* ld_ptr(LAS unsigned char* lds, int i) {
    const volatile LAS unsigned* p = (const volatile LAS unsigned*)(lds + PTAB_OFF) + 2 * i;
    const unsigned lo = __builtin_amdgcn_readfirstlane(p[0]), hi = __builtin_amdgcn_readfirstlane(p[1]);
    return (void*)(((unsigned long long)hi << 32) | lo);
}
DI int bidx_of_row(int row) { return row < MCTX ? 0 : 1 + ((row - MCTX) >> 12); }

DI f32x4 mfma16(bf16x8 a, bf16x8 b, f32x4 c) { return __builtin_amdgcn_mfma_f32_16x16x32_bf16(a, b, c, 0, 0, 0); }
DI f32x4 mma_tile(f32x4 acc, const LAS bf16_t* A, int lda, const LAS bf16_t* Bt, int ldb, int K, int lane) {
    const int r = lane & 15, q = lane >> 4;
    const LAS bf16_t* ap = A + r * lda + q * 8;
    const LAS bf16_t* bp = Bt + r * ldb + q * 8;
    for (int k0 = 0; k0 < K; k0 += 32) {
        bf16x8 a = *(const LAS bf16x8*)(ap + k0);
        bf16x8 b = *(const LAS bf16x8*)(bp + k0);
        acc = mfma16(a, b, acc);
    }
    return acc;
}

namespace pg8 {
constexpr int BM = 256, BK = 64, HALF = 128, HTB = HALF * BK * 2, NXCD = 8, WGM = 8;
DI int lds_byte(int r, int c) { const int st = (r >> 4) * 2 + (c >> 5), rr = r & 15, cc = c & 31, ob = rr * 64 + cc * 2; return st * 1024 + (ob ^ (((ob >> 9) & 1) << 5)); }
DI void stage_rc(int b, int& R, int& C) { const int st = b / 1024, sb = b % 1024, swz = sb ^ (((sb >> 9) & 1) << 5); R = (st >> 1) * 16 + swz / 64; C = (st & 1) * 32 + (swz % 64) / 2; }
DI int perm32(int rho) { const int n = rho >> 4, i = rho & 15; return 8 * (i >> 2) + 4 * n + (i & 3); }
struct Unit { int pm, pn, br; };
struct Sched {
    int nM, nN, nwg, G, c, nsub, K;
    const char* A0; size_t asub; const char* B0; size_t bsub;
    const float* pre_rq; const float* pre_sw; int pre_ld; bool pre;
    DI bool next(int i, Unit& u) const {
        const int ib = i / nsub; u.br = i - ib * nsub;
        const long L = (long)ib * G + c; if (L >= nwg) return false;
        int wgid = (int)L; { const int q = nwg / NXCD, r = nwg % NXCD, xcd = wgid % NXCD, off = wgid / NXCD; wgid = (xcd < r ? xcd * (q + 1) : r * (q + 1) + (xcd - r) * q) + off; }
        const int nig = WGM * nN, gid = wgid / nig, fm = gid * WGM, gsz = (nM - fm) < WGM ? (nM - fm) : WGM;
        u.pm = fm + ((wgid % nig) % gsz); u.pn = (wgid % nig) / gsz; return true;
    }
    DI const char* aptr(const Unit& u) const { return A0 + (size_t)u.br * asub + (size_t)u.pm * (size_t)(BM * 2) * K; }
    DI const char* bptr(const Unit& u) const { return B0 + (size_t)u.br * bsub + (size_t)u.pn * (size_t)(BM * 2) * K; }
};
typedef f32x4 acc_t[2][2][4][2];

template <class Epi>
DI void gemm_phase(LAS unsigned char* lds, const Sched& S, const Epi& E) {
    const int tid = tid_opaque(), wid = __builtin_amdgcn_readfirstlane(tid >> 6), lane = tid & 63, wr = wid >> 2, wc = wid & 3, fr = lane & 15, fq = lane >> 4;
    const int K = S.K, nt = K / BK;
    unsigned voffA[2], voffB[2];
#pragma unroll
    for (int i = 0; i < 2; ++i) { int R, C; stage_rc(tid * 16 + i * 8192, R, C); const int Rb = (R & ~31) + perm32(R & 31);
        voffA[i] = (unsigned)(R * K + C) * 2u; voffB[i] = (unsigned)(Rb * K + C) * 2u; }
    const size_t kstep = (size_t)(BK * 2);
    const size_t hstep = (size_t)HALF * K * 2;
    const unsigned ldsw = (unsigned)wid * 1024u;
    const int aoff = lds_byte(wr * 64 + fr, fq * 8), boff = lds_byte(wc * 32 + fr, fq * 8);
#define PG8_SA(b, h) (((b) * 2 + (h)) * HTB)
#define PG8_SB(b, h) ((4 + (b) * 2 + (h)) * HTB)
#define PG8_STAGE(bufoff, gbase, voff) do { _Pragma("unroll") for (int _i = 0; _i < 2; ++_i) \
        __builtin_amdgcn_global_load_lds((const unsigned*)((const char*)(gbase) + (voff)[_i]), (LAS unsigned*)(lds + (bufoff) + ldsw + _i * 8192), 16, 0, 0); } while (0)
#define PG8_LDA(dst, b, h) do { _Pragma("unroll") for (int m = 0; m < 4; ++m) _Pragma("unroll") for (int k = 0; k < 2; ++k) dst[m][k] = *(const LAS bf16x8*)(lds + PG8_SA(b, h) + aoff + m * 2048 + k * 1024); } while (0)
#define PG8_LDB(dst, b, h) do { _Pragma("unroll") for (int n = 0; n < 2; ++n) _Pragma("unroll") for (int k = 0; k < 2; ++k) dst[n][k] = *(const LAS bf16x8*)(lds + PG8_SB(b, h) + boff + n * 2048 + k * 1024); } while (0)
#define PG8_MMA(ai, bj, At, Bt) do { __builtin_amdgcn_s_setprio(1); _Pragma("unroll") for (int m = 0; m < 4; ++m) _Pragma("unroll") for (int n = 0; n < 2; ++n) _Pragma("unroll") for (int k = 0; k < 2; ++k) \
        acc[ai][bj][m][n] = __builtin_amdgcn_mfma_f32_16x16x32_bf16(Bt[n][k], At[m][k], acc[ai][bj][m][n], 0, 0, 0); __builtin_amdgcn_s_setprio(0); } while (0)
#define PG8_WAIT_V(n) asm volatile("s_waitcnt vmcnt(" #n ")" ::: "memory")
#define PG8_WAIT_L(n) asm volatile("s_waitcnt lgkmcnt(" #n ")" ::: "memory")
#define PG8_BAR __builtin_amdgcn_s_barrier()
#define PG8_SCHED __builtin_amdgcn_sched_barrier(0)
    Unit cur, nxt; int ui = 0;
    if (!S.next(0, cur)) return;
    acc_t acc;
#pragma unroll
    for (int a = 0; a < 2; ++a)
#pragma unroll
        for (int b = 0; b < 2; ++b)
#pragma unroll
            for (int m = 0; m < 4; ++m)
#pragma unroll
                for (int n = 0; n < 2; ++n) acc[a][b][m][n] = (f32x4){0.f, 0.f, 0.f, 0.f};
    bf16x8 At[4][2], B0[2][2], B1[2][2];
    const char* cA = S.aptr(cur); const char* cB = S.bptr(cur);
    PG8_STAGE(PG8_SB(0, 0), cB, voffB); PG8_STAGE(PG8_SA(0, 0), cA, voffA); PG8_STAGE(PG8_SB(0, 1), cB + hstep, voffB); PG8_STAGE(PG8_SA(0, 1), cA + hstep, voffA);
    if (wr == 1) PG8_BAR;
    PG8_WAIT_V(4); PG8_BAR;
    PG8_STAGE(PG8_SB(1, 0), cB + kstep, voffB); PG8_STAGE(PG8_SA(1, 0), cA + kstep, voffA); PG8_STAGE(PG8_SB(1, 1), cB + hstep + kstep, voffB);
    PG8_WAIT_V(6); PG8_BAR;
    for (;;) {
        const bool has_next = S.next(ui + 1, nxt);
        const char* nA = has_next ? S.aptr(nxt) : cA; const char* nB = has_next ? S.bptr(nxt) : cB;
        LAS unsigned char* epi_lds = lds + 131072 + (ui & 1) * 2048;
        if (S.pre && wid == 0) {
            const float* rq = S.pre_rq + cur.pm * 256 + lane * 4;
            const float* sw = S.pre_sw + (size_t)bidx_of_row(cur.pm * 256) * S.pre_ld + cur.pn * 256 + lane * 4;
            __builtin_amdgcn_global_load_lds((const unsigned*)rq, (LAS unsigned*)(epi_lds), 16, 0, 0);
            __builtin_amdgcn_global_load_lds((const unsigned*)sw, (LAS unsigned*)(epi_lds + 1024), 16, 0, 0);
        }
        for (int t = 0; t < nt; t += 2) {
            const bool last = (t == nt - 2);
            const char* a1 = cA + (size_t)(t + 1) * kstep;
            const char* a2 = last ? nA : cA + (size_t)(t + 2) * kstep; const char* b2 = last ? nB : cB + (size_t)(t + 2) * kstep;
            const char* a3 = a2 + kstep; const char* b3 = b2 + kstep;
            PG8_LDB(B0, 0, 0); PG8_SCHED; PG8_LDA(At, 0, 0); PG8_STAGE(PG8_SA(1, 1), a1 + hstep, voffA);
            PG8_WAIT_L(8); PG8_BAR; PG8_WAIT_L(0); PG8_MMA(0, 0, At, B0); PG8_BAR; PG8_SCHED;
            PG8_LDB(B1, 0, 1); PG8_STAGE(PG8_SB(0, 0), b2, voffB);
            PG8_BAR; PG8_WAIT_L(0); PG8_MMA(0, 1, At, B1); PG8_BAR;
            PG8_LDA(At, 0, 1); PG8_STAGE(PG8_SA(0, 0), a2, voffA);
            PG8_BAR; PG8_WAIT_L(0); PG8_MMA(1, 0, At, B0); PG8_BAR; PG8_SCHED;
            PG8_STAGE(PG8_SB(0, 1), b2 + hstep, voffB);
            PG8_WAIT_V(6); PG8_BAR; PG8_MMA(1, 1, At, B1); PG8_BAR;
            PG8_LDB(B0, 1, 0); PG8_SCHED; PG8_LDA(At, 1, 0); PG8_STAGE(PG8_SA(0, 1), a2 + hstep, voffA);
            PG8_WAIT_L(8); PG8_BAR; PG8_WAIT_L(0); PG8_MMA(0, 0, At, B0); PG8_BAR; PG8_SCHED;
            PG8_LDB(B1, 1, 1); PG8_STAGE(PG8_SB(1, 0), b3, voffB);
            PG8_BAR; PG8_WAIT_L(0); PG8_MMA(0, 1, At, B1); PG8_BAR;
            PG8_LDA(At, 1, 1); PG8_STAGE(PG8_SA(1, 0), a3, voffA);
            PG8_BAR; PG8_WAIT_L(0); PG8_MMA(1, 0, At, B0); PG8_BAR; PG8_SCHED;
            PG8_STAGE(PG8_SB(1, 1), b3 + hstep, voffB);
            PG8_WAIT_V(6); PG8_BAR; PG8_MMA(1, 1, At, B1); PG8_BAR;
        }
        E(acc, cur, wr, wc, fr, fq, epi_lds);
        if (!has_next) break;
#pragma unroll
        for (int a = 0; a < 2; ++a)
#pragma unroll
            for (int b = 0; b < 2; ++b)
#pragma unroll
                for (int m = 0; m < 4; ++m)
#pragma unroll
                    for (int n = 0; n < 2; ++n) acc[a][b][m][n] = (f32x4){0.f, 0.f, 0.f, 0.f};
        cur = nxt; cA = nA; cB = nB; ++ui;
    }
    PG8_WAIT_V(0);
    if (wr == 0) PG8_BAR;
    PG8_BAR;
#undef PG8_SA
#undef PG8_SB
#undef PG8_STAGE
#undef PG8_LDA
#undef PG8_LDB
#undef PG8_MMA
#undef PG8_WAIT_V
#undef PG8_WAIT_L
#undef PG8_BAR
#undef PG8_SCHED
}
}
using pg8::Unit;
using pg8::acc_t;

DI u32x4 pk8(f32x4 a, f32x4 b) { u32x4 w; w.x = pk2(a[0], a[1]); w.y = pk2(a[2], a[3]); w.z = pk2(b[0], b[1]); w.w = pk2(b[2], b[3]); return w; }
struct EpiAll {
    int mode, layer; bool dry;
    unsigned char* ws; float* out; const float* xp; const float* xs; const float* lng_next;
    bf16_t* hs; bf16_t* oth;
    DI void operator()(const acc_t& acc, const Unit& u, int wr, int wc, int fr_in, int fq_in, const LAS unsigned char* pre) const {
        if (dry) return;
        int fr = fr_in, fq = fq_in; asm volatile("" : "+v"(fr), "+v"(fq));
        const int pn = u.pn, br = u.br;
        const int row0 = u.pm * 256 + wr * 64 + fr, cin = wc * 32 + 8 * fq;
        const int bidx = bidx_of_row(u.pm * 256);
        if (mode == 0) {
            const LAS float* rowsq = (const LAS float*)pre;
            const LAS float* sw = (const LAS float*)(pre + 1024) + cin;
            f32x4 sv[2][2];
#pragma unroll
            for (int bj = 0; bj < 2; ++bj)
#pragma unroll
                for (int n = 0; n < 2; ++n) sv[bj][n] = *(const LAS f32x4*)(sw + bj * 128 + 4 * n);
            size_t doff; int tb, ldd; bool act;
            if (pn < 6) { doff = OFF_QKV; tb = pn; ldd = 1536; act = false; }
            else if (pn < 8) { doff = OFF_ZA; tb = pn - 6; ldd = 512; act = true; }
            else if (pn < 12) { doff = OFF_UBZ; tb = 0; ldd = 512; act = false; }
            else if (pn < 14) { doff = (layer & 1) ? OFF_X : OFF_Y; tb = pn - 12; ldd = 512; act = false; }
            else if (pn < 16) { doff = OFF_XC; tb = pn - 14; ldd = 512; act = false; }
            else { doff = OFF_ZC; tb = pn - 16; ldd = 512; act = true; }
            bf16_t* dst = (bf16_t*)(ws + doff) + tb * 256 + cin;
            bf16_t* HALO = (bf16_t*)(ws + OFF_HALO) + pn * 256 + cin;
#pragma unroll
            for (int ai = 0; ai < 2; ++ai) {
                float rq[4];
#pragma unroll
                for (int m = 0; m < 4; ++m) rq[m] = rowsq[wr * 64 + fr + ai * 128 + m * 16];
#pragma unroll
                for (int m = 0; m < 4; ++m) {
                    const int row = row0 + ai * 128 + m * 16;
                    const float rinv = rsqrtf(rq[m] * (1.0f / DM) + EPS);
                    if (pn >= 8 && pn < 12) {
                        f32x4 o[2];
#pragma unroll
                        for (int n = 0; n < 2; ++n) {
                            const f32x4 uu = acc[ai][0][m][n] * rinv + sv[0][n], zz = acc[ai][1][m][n] * rinv + sv[1][n];
#pragma unroll
                            for (int j = 0; j < 4; ++j) o[n][j] = uu[j] * silu(zz[j]);
                        }
                        *(u32x4*)(dst + (size_t)row * 512 + (pn - 8) * 128) = pk8(o[0], o[1]);
                    } else if (pn == 18) {
                        if (wc == 0 && fq < 2) {
#pragma unroll
                            for (int n = 0; n < 2; ++n) *(f32x4*)((float*)(ws + OFF_BD) + (size_t)row * 16 + 8 * fq + 4 * n) = acc[ai][0][m][n] * rinv + sv[0][n];
                        }
                    } else {
#pragma unroll
                        for (int bj = 0; bj < 2; ++bj) {
                            f32x4 a = acc[ai][bj][m][0] * rinv + sv[bj][0], b = acc[ai][bj][m][1] * rinv + sv[bj][1];
                            if (act) {
#pragma unroll
                                for (int j = 0; j < 4; ++j) { a[j] = silu(a[j]); b[j] = silu(b[j]); }
                            }
                            const u32x4 w = pk8(a, b);
                            *(u32x4*)(dst + (size_t)row * ldd + bj * 128) = w;
                            if (pn < 6) {
                                if ((row & 63) == 0) *(u32x4*)(HALO + ((size_t)(row >> 6) * 2 + 0) * 1536 + bj * 128) = w;
                                if ((row & 63) == 63) *(u32x4*)(HALO + ((size_t)(row >> 6) * 2 + 1) * 1536 + bj * 128) = w;
                            }
                        }
                    }
                }
                asm volatile("" ::: "memory");
            }
        } else if (mode == 1) {
            const LAS float* rowsq = (const LAS float*)pre;
            const LAS float* sw = (const LAS float*)(pre + 1024) + cin;
            bf16_t* GT = (bf16_t*)(ws + OFF_G) + pn * 256 + cin;
            f32x4 sv[2][2];
#pragma unroll
            for (int bj = 0; bj < 2; ++bj)
#pragma unroll
                for (int n = 0; n < 2; ++n) sv[bj][n] = *(const LAS f32x4*)(sw + bj * 128 + 4 * n);
#pragma unroll
            for (int ai = 0; ai < 2; ++ai) {
                float rq[4];
#pragma unroll
                for (int m = 0; m < 4; ++m) rq[m] = rowsq[wr * 64 + fr + ai * 128 + m * 16];
#pragma unroll
                for (int m = 0; m < 4; ++m) {
                    const int row = row0 + ai * 128 + m * 16;
                    const float rinv = rsqrtf(rq[m] * (1.0f / DM) + EPS);
#pragma unroll
                    for (int bj = 0; bj < 2; ++bj) {
                        f32x4 a = acc[ai][bj][m][0] * rinv + sv[bj][0], b = acc[ai][bj][m][1] * rinv + sv[bj][1];
#pragma unroll
                        for (int j = 0; j < 4; ++j) { a[j] = sigm(a[j]); b[j] = sigm(b[j]); }
                        *(u32x4*)(GT + (size_t)row * NGATE + bj * 128) = pk8(a, b);
                    }
                }
                asm volatile("" ::: "memory");
            }
        } else if (mode == 2) {
            const bf16_t* GT = (const bf16_t*)(ws + OFF_G) + br * 1024 + pn * 256 + cin;
            bf16_t* MG = hs + pn * 256 + cin;
#pragma unroll
            for (int hm = 0; hm < 4; ++hm) {
                const int ai = hm >> 1, mb = (hm & 1) * 2;
                u32x4 gc[2][2], pv[2][2];
#pragma unroll
                for (int mm = 0; mm < 2; ++mm)
#pragma unroll
                    for (int bj = 0; bj < 2; ++bj) gc[mm][bj] = *(const u32x4*)(GT + (size_t)(row0 + ai * 128 + (mb + mm) * 16) * NGATE + bj * 128);
                if (br > 0) {
                    bf16_t* p0 = MG + (size_t)(row0 + ai * 128 + mb * 16) * 1024;
                    asm volatile("global_load_dwordx4 %0, %4, off sc1\n\tglobal_load_dwordx4 %1, %4, off offset:256 sc1\n\t"
                                 "global_load_dwordx4 %2, %5, off sc1\n\tglobal_load_dwordx4 %3, %5, off offset:256 sc1\n\ts_waitcnt vmcnt(0)"
                                 : "=&v"(pv[0][0]), "=&v"(pv[0][1]), "=&v"(pv[1][0]), "=&v"(pv[1][1])
                                 : "v"(p0), "v"(p0 + 16 * 1024) : "memory");
                }
#pragma unroll
                for (int mm = 0; mm < 2; ++mm)
#pragma unroll
                    for (int bj = 0; bj < 2; ++bj) {
                        const u32x4 g = gc[mm][bj];
                        f32x4 a = acc[ai][bj][mb + mm][0] * (f32x4){bflo(g.x), bfhi(g.x), bflo(g.y), bfhi(g.y)};
                        f32x4 b = acc[ai][bj][mb + mm][1] * (f32x4){bflo(g.z), bfhi(g.z), bflo(g.w), bfhi(g.w)};
                        if (br > 0) {
                            const u32x4 p = pv[mm][bj];
                            a = a + (f32x4){bflo(p.x), bfhi(p.x), bflo(p.y), bfhi(p.y)};
                            b = b + (f32x4){bflo(p.z), bfhi(p.z), bflo(p.w), bfhi(p.w)};
                        }
                        *(u32x4*)(MG + (size_t)(row0 + ai * 128 + (mb + mm) * 16) * 1024 + bj * 128) = pk8(a, b);
                    }
                asm volatile("" ::: "memory");
            }
        } else {
            const float* hold = (layer == 0) ? (u.pm < 16 ? xp : xs - (size_t)MCTX * DM) : out;
            const float* gate = (const float*)(ws + OFF_MOD) + ((size_t)layer * 9 + bidx) * 3072 + 2048 + pn * 256 + cin;
            const float* gsc = (const float*)(ws + OFF_MOD) + ((size_t)(layer + 1 < NLAYER ? layer + 1 : layer) * 9 + bidx) * 3072 + 1024 + pn * 256 + cin;
            const float* lgn = lng_next + pn * 256 + cin;
            float* rsq = (float*)(ws + OFF_ROWSQ) + (size_t)(layer + 1) * MTOT;
            f32x4 gv[2][2], gs[2][2];
#pragma unroll
            for (int bj = 0; bj < 2; ++bj)
#pragma unroll
                for (int n = 0; n < 2; ++n) {
                    gv[bj][n] = *(const f32x4*)(gate + bj * 128 + 4 * n);
                    if (layer < 3) { const f32x4 lg = *(const f32x4*)(lgn + bj * 128 + 4 * n); const f32x4 sc = *(const f32x4*)(gsc + bj * 128 + 4 * n); gs[bj][n] = lg * (sc + 1.0f); }
                    else gs[bj][n] = (f32x4){0.f, 0.f, 0.f, 0.f};
                }
#pragma unroll
            for (int ai = 0; ai < 2; ++ai)
#pragma unroll
                for (int m = 0; m < 4; ++m) {
                    const int row = row0 + ai * 128 + m * 16;
                    float ss = 0.f;
#pragma unroll
                    for (int bj = 0; bj < 2; ++bj) {
                        const size_t off = (size_t)row * DM + pn * 256 + cin + bj * 128;
                        const f32x4 h0 = *(const f32x4*)(hold + off), h1 = *(const f32x4*)(hold + off + 4);
                        const f32x4 hn0 = h0 + gv[bj][0] * acc[ai][bj][m][0], hn1 = h1 + gv[bj][1] * acc[ai][bj][m][1];
                        *(f32x4*)(out + off) = hn0; *(f32x4*)(out + off + 4) = hn1;
                        ss += (hn0[0] * hn0[0] + hn0[1] * hn0[1]) + (hn0[2] * hn0[2] + hn0[3] * hn0[3]) + (hn1[0] * hn1[0] + hn1[1] * hn1[1]) + (hn1[2] * hn1[2] + hn1[3] * hn1[3]);
                        if (layer < 3) *(u32x4*)(oth + off) = pk8(hn0 * gs[bj][0], hn1 * gs[bj][1]);
                    }
                    ss += __shfl_xor(ss, 16); ss += __shfl_xor(ss, 32);
                    if (fq == 0) atomicAdd(rsq + row, ss);
                    if (m == 3) asm volatile("" ::: "memory");
                }
        }
    }
};

DI int colmap1(int n) {
    const int t = n >> 8, o = n & 255;
    if (t < 6) return n;
    if (t < 8) return 1552 + (n - 1536);
    if (t < 12) { const int i = t - 8; return o < 128 ? 2064 + 128 * i + o : 3088 + 128 * i + (o - 128); }
    if (t < 14) return 2576 + (n - 3072);
    if (t < 16) return 3600 + (n - 3584);
    if (t < 18) return 4112 + (n - 4096);
    return o < 16 ? 1536 + o : -1;
}
DI void transpose_item(const float* W, int Nsrc, int K, bf16_t* WT, int nblk, int mapkind, LAS float* scr, int item, int lane) {
    const int kb = item / nblk, nb = item % nblk, k0 = 64 * kb, n0 = 32 * nb;
    const int nn = n0 + (lane & 31);
    const int e = mapkind == 0 ? nn : (mapkind == 1 ? colmap1(nn) : 4624 + nn);
#pragma unroll 8
    for (int i = 0; i < 32; ++i) { const int kk = 2 * i + (lane >> 5); scr[kk * 33 + (lane & 31)] = e >= 0 ? W[(size_t)(k0 + kk) * Nsrc + e] : 0.f; }
    asm volatile("s_waitcnt lgkmcnt(0)" ::: "memory");
    const int c = lane & 7;
#pragma unroll
    for (int j = 0; j < 4; ++j) { const int n = (lane >> 3) + 8 * j; const LAS float* s = scr + (8 * c) * 33 + n;
        u32x4 o; o.x = pk2(s[0 * 33], s[1 * 33]); o.y = pk2(s[2 * 33], s[3 * 33]); o.z = pk2(s[4 * 33], s[5 * 33]); o.w = pk2(s[6 * 33], s[7 * 33]);
        *(u32x4*)(WT + (size_t)(n0 + n) * K + k0 + 8 * c) = o; }
    asm volatile("s_waitcnt lgkmcnt(0)" ::: "memory");
}
DI void transpose_seg(const float* W, int Nsrc, int K, bf16_t* WT, int Ndst, int mapkind, LAS float* scr, int gw, int NGW, int lane) {
    const int nblk = Ndst / 32, nitems = (K / 64) * nblk;
    for (int it = gw; it < nitems; it += NGW) transpose_item(W, Nsrc, K, WT, nblk, mapkind, scr, it, lane);
}

DI void gemv9_item(const LAS float* in_s, LAS float* red, const float* W, int ldw, int mapkind, const float* bias, float* out, int ldo, int n0) {
    const int t = tid_opaque(), col = t & 63, part = t >> 6;
    const int nn = n0 + col;
    const int e = mapkind == 0 ? nn : (mapkind == 1 ? colmap1(nn) : 4624 + nn);
    float a[9];
#pragma unroll
    for (int j = 0; j < 9; ++j) a[j] = 0.f;
    if (e >= 0) {
        const float* wp = W + (size_t)(part * 128) * ldw + e;
        for (int d = 0; d < 128; d += 4) {
            const float w0 = wp[(size_t)(d + 0) * ldw], w1 = wp[(size_t)(d + 1) * ldw], w2 = wp[(size_t)(d + 2) * ldw], w3 = wp[(size_t)(d + 3) * ldw];
#pragma unroll
            for (int j = 0; j < 9; ++j) { const f32x4 x = *(const LAS f32x4*)(in_s + j * 1024 + part * 128 + d); a[j] += (x[0] * w0 + x[1] * w1) + (x[2] * w2 + x[3] * w3); }
        }
    }
#pragma unroll
    for (int j = 0; j < 9; ++j) red[(part * 9 + j) * 64 + col] = a[j];
    __syncthreads();
    for (int o = t; o < 9 * 64; o += NTHREADS) {
        const int j = o >> 6, c = o & 63;
        const int n2 = n0 + c;
        const int e2 = mapkind == 0 ? n2 : (mapkind == 1 ? colmap1(n2) : 4624 + n2);
        float sm = 0.f;
#pragma unroll
        for (int p = 0; p < 8; ++p) sm += red[(p * 9 + j) * 64 + c];
        if (e2 >= 0 && bias) sm += bias[e2];
        out[(size_t)j * ldo + n2] = (e2 >= 0) ? sm : 0.f;
    }
    __syncthreads();
}

DI void d1_item(const bool dry, LAS unsigned char* lds, int item, bf16_t* QKV, const bf16_t* HALO, const float* BD, const float* convw, float* GB, bf16_t* TQ, const float* alog, const float* dtb) {
    const int t = tid_opaque(), lane = t & 63, wid = __builtin_amdgcn_readfirstlane(t >> 6);
    const int cg_ = item >> 2, h = item & 3;
    const int rowbase = cg_ * 64;
    int cin_seq, nch;
    if (rowbase < MCTX) { cin_seq = cg_ & 3; nch = 4; } else { cin_seq = (cg_ - 64) & 63; nch = 64; }
    LAS bf16_t* Qs = (LAS bf16_t*)lds;
    LAS bf16_t* Ks = Qs + 64 * 136;
    LAS float* KK = (LAS float*)(lds + 2 * 64 * 136 * 2);
    LAS float* As = KK + 64 * 65;
    LAS float* graw = As + 2 * 64 * 68;
    LAS float* braw = graw + 128;
    LAS float* gam = braw + 128;
    LAS float* bet = gam + 128;
    {
        const int c8 = (t & 15) * 8, rg = t >> 4;
#pragma unroll 1
        for (int ten = 0; ten < 3; ++ten) {
            float res[2][8];
            const int col = ten * 512 + h * 128 + c8;
            {
                u32x4 x[4];
#pragma unroll
                for (int rr = 0; rr < 4; ++rr) {
                    const int li = 2 * rg - 1 + rr;
                    if (li < 0) x[rr] = (cin_seq == 0) ? (u32x4){0u, 0u, 0u, 0u} : *(const u32x4*)(HALO + ((size_t)(cg_ - 1) * 2 + 1) * 1536 + col);
                    else if (li > 63) x[rr] = (cin_seq == nch - 1) ? (u32x4){0u, 0u, 0u, 0u} : *(const u32x4*)(HALO + ((size_t)(cg_ + 1) * 2 + 0) * 1536 + col);
                    else x[rr] = *(const u32x4*)(QKV + (size_t)(rowbase + li) * 1536 + col);
                }
                float w[3][8];
#pragma unroll
                for (int j = 0; j < 3; ++j) { const f32x4 a = *(const f32x4*)(convw + j * 1536 + col), b = *(const f32x4*)(convw + j * 1536 + col + 4);
                    w[j][0] = a[0]; w[j][1] = a[1]; w[j][2] = a[2]; w[j][3] = a[3]; w[j][4] = b[0]; w[j][5] = b[1]; w[j][6] = b[2]; w[j][7] = b[3]; }
                float xf[4][8];
#pragma unroll
                for (int rr = 0; rr < 4; ++rr) { xf[rr][0] = bflo(x[rr].x); xf[rr][1] = bfhi(x[rr].x); xf[rr][2] = bflo(x[rr].y); xf[rr][3] = bfhi(x[rr].y);
                    xf[rr][4] = bflo(x[rr].z); xf[rr][5] = bfhi(x[rr].z); xf[rr][6] = bflo(x[rr].w); xf[rr][7] = bfhi(x[rr].w); }
#pragma unroll
                for (int o = 0; o < 2; ++o)
#pragma unroll
                    for (int e = 0; e < 8; ++e) res[o][e] = silu(w[0][e] * xf[o][e] + w[1][e] * xf[o + 1][e] + w[2][e] * xf[o + 2][e]);
            }
            if (ten < 2) {
#pragma unroll
                for (int o = 0; o < 2; ++o) {
                    float s = 0.f;
#pragma unroll
                    for (int e = 0; e < 8; ++e) s += res[o][e] * res[o][e];
                    s += __shfl_xor(s, 1); s += __shfl_xor(s, 2); s += __shfl_xor(s, 4); s += __shfl_xor(s, 8);
                    const float sc = rsqrtf(s + EPS) * (ten == 0 ? 0.08838834764831845f : 1.0f);
#pragma unroll
                    for (int e = 0; e < 8; ++e) res[o][e] *= sc;
                }
            }
            __syncthreads();
#pragma unroll
            for (int o = 0; o < 2; ++o) {
                u32x4 w; w.x = pk2(res[o][0], res[o][1]); w.y = pk2(res[o][2], res[o][3]); w.z = pk2(res[o][4], res[o][5]); w.w = pk2(res[o][6], res[o][7]);
                const int li = 2 * rg + o;
                if (!dry) *(u32x4*)(QKV + (size_t)(rowbase + li) * 1536 + col) = w;
                if (ten == 0) *(LAS u32x4*)(Qs + li * 136 + c8) = w;
                if (ten == 1) *(LAS u32x4*)(Ks + li * 136 + c8) = w;
            }
        }
        if (t < 128) { const int d = t >> 6, i = t & 63; graw[t] = -__expf(alog[d * 4 + h]) * softplus(BD[(size_t)(rowbase + i) * 16 + 8 + d * 4 + h] + dtb[d * 4 + h]); braw[t] = sigm(BD[(size_t)(rowbase + i) * 16 + d * 4 + h]); }
    }
    __syncthreads();
#pragma unroll
    for (int tt = 0; tt < 2; ++tt) {
        const int tile = wid * 2 + tt, mi = tile >> 2, ni = tile & 3;
        f32x4 acc = (f32x4){0.f, 0.f, 0.f, 0.f};
        acc = mma_tile(acc, Ks + mi * 16 * 136, 136, Ks + ni * 16 * 136, 136, 128, lane);
#pragma unroll
        for (int j = 0; j < 4; ++j) KK[(mi * 16 + (lane >> 4) * 4 + j) * 65 + ni * 16 + (lane & 15)] = acc[j];
    }
    if (t < 128) {
        const int d = t >> 6, ip = t & 63, oi = d ? 63 - ip : ip;
        float g = graw[d * 64 + oi];
#pragma unroll
        for (int o = 1; o < 64; o <<= 1) { const float y = __shfl_up(g, o); if (ip >= o) g += y; }
        const float b = braw[d * 64 + oi];
        gam[t] = g; bet[t] = b;
        float* gb = GB + ((size_t)(cg_ * 4 + h) * 2 + d) * 128;
        if (!dry) { gb[ip] = g; gb[64 + ip] = b; }
    }
    __syncthreads();
    for (int e = t; e < 2 * 4096; e += NTHREADS) {
        const int d = e >> 12, ip = (e >> 6) & 63, jp = e & 63;
        float v = 0.f;
        if (ip > jp) { const int oi = d ? 63 - ip : ip, oj = d ? 63 - jp : jp; v = bet[d * 64 + ip] * KK[oi * 65 + oj] * __expf(gam[d * 64 + ip] - gam[d * 64 + jp]); }
        As[(d * 64 + ip) * 68 + jp] = v;
    }
    __syncthreads();
    if (t < 128) {
        const int d = t >> 6, c = t & 63;
        const LAS float* Ad = As + d * 64 * 68;
        float x[64];
#pragma unroll
        for (int i = 0; i < 64; ++i) {
            float s = (i == c) ? 1.f : 0.f;
#pragma unroll
            for (int j4 = 0; j4 < (i + 3) / 4; ++j4) {
                const f32x4 a = *(const LAS f32x4*)(Ad + i * 68 + j4 * 4);
#pragma unroll
                for (int jj = 0; jj < 4; ++jj) { if (j4 * 4 + jj < i) s -= a[jj] * x[j4 * 4 + jj]; }
            }
            x[i] = s;
        }
        bf16_t* tq = TQ + ((size_t)(cg_ * 4 + h) * 2 + d) * 4096;
#pragma unroll
        for (int i = 0; i < 64; ++i) if (!dry) tq[i * 64 + c] = (bf16_t)f2bf(x[i]);
    }
    __syncthreads();
}

DI void sgu_item(const bool dry, LAS unsigned char* lds, int item, const bf16_t* VB, bf16_t* UBZ, const float* gnorm, const float* wsp, const float* bsp) {
    const int t = tid_opaque(), lane = t & 63, wid = __builtin_amdgcn_readfirstlane(t >> 6);
    const int cb = item >> 2, g = item & 3, r0 = cb * 128;
    LAS bf16_t* Ws = (LAS bf16_t*)lds;
    LAS bf16_t* VT = Ws + 128 * 136;
    LAS float* rinv = (LAS float*)(lds + 2 * 128 * 136 * 2);
    {
        const int q = t >> 2, sub = t & 3;
        const bf16_t* vp = VB + (size_t)(r0 + q) * 512 + sub * 128;
        float s = 0.f;
#pragma unroll
        for (int i = 0; i < 16; ++i) { const u32x4 x = *(const u32x4*)(vp + i * 8);
            const float a0 = bflo(x.x), a1 = bfhi(x.x), a2 = bflo(x.y), a3 = bfhi(x.y), a4 = bflo(x.z), a5 = bfhi(x.z), a6 = bflo(x.w), a7 = bfhi(x.w);
            s += (a0 * a0 + a1 * a1) + (a2 * a2 + a3 * a3) + (a4 * a4 + a5 * a5) + (a6 * a6 + a7 * a7); }
        s += __shfl_xor(s, 1); s += __shfl_xor(s, 2);
        if (sub == 0) rinv[q] = rsqrtf(s * (1.0f / 512.0f) + EPS);
        for (int e = t; e < 128 * 32; e += NTHREADS) { const int p = e >> 5, c4 = (e & 31) * 4; const f32x4 w = *(const f32x4*)(wsp + (size_t)g * 16384 + p * 128 + c4);
            u32x2 o; o.x = pk2(w[0], w[1]); o.y = pk2(w[2], w[3]); *(LAS u32x2*)(Ws + p * 136 + c4) = o; }
    }
    __syncthreads();
    {
        const int q = t >> 2, sub = t & 3;
        const float ri = rinv[q];
#pragma unroll
        for (int i = 0; i < 4; ++i) {
            const int c0 = sub * 32 + i * 8;
            const u32x4 x = *(const u32x4*)(VB + (size_t)(r0 + q) * 512 + g * 128 + c0);
            const f32x4 g0 = *(const f32x4*)(gnorm + g * 128 + c0), g1 = *(const f32x4*)(gnorm + g * 128 + c0 + 4);
            const float v[8] = {bflo(x.x) * ri * g0[0], bfhi(x.x) * ri * g0[1], bflo(x.y) * ri * g0[2], bfhi(x.y) * ri * g0[3], bflo(x.z) * ri * g1[0], bfhi(x.z) * ri * g1[1], bflo(x.w) * ri * g1[2], bfhi(x.w) * ri * g1[3]};
#pragma unroll
            for (int e = 0; e < 8; ++e) VT[(c0 + e) * 136 + q] = (bf16_t)f2bf(v[e]);
        }
    }
    __syncthreads();
#pragma unroll 1
    for (int ni = 0; ni < 8; ++ni) {
        f32x4 acc = (f32x4){0.f, 0.f, 0.f, 0.f};
        acc = mma_tile(acc, Ws + wid * 16 * 136, 136, VT + ni * 16 * 136, 136, 128, lane);
        const int c = g * 128 + ni * 16 + (lane & 15);
#pragma unroll
        for (int j = 0; j < 4; ++j) {
            const int p = wid * 16 + (lane >> 4) * 4 + j;
            bf16_t* up = UBZ + (size_t)(r0 + p) * 512 + c;
            const float o = bf2f(*up) * (acc[j] + bsp[g * 128 + p]);
            if (!dry) *up = (bf16_t)f2bf(o);
        }
    }
    __syncthreads();
}

DI void f1_load_tables(LAS unsigned char* lds, const bf16_t* tab) {
    LAS bf16_t* Fs = (LAS bf16_t*)lds;
    LAS bf16_t* M2s = Fs + 256 * 136;
    const bf16_t* FCH = tab + TAB_FCH / 2; const bf16_t* M2 = tab + TAB_M2 / 2;
    const int t0_ = tid_opaque();
    for (int e = t0_; e < 256 * 16; e += NTHREADS) { const int r = e >> 4, c8 = (e & 15) * 8; *(LAS u32x4*)(Fs + r * 136 + c8) = *(const u32x4*)(FCH + r * 128 + c8); }
    for (int e = t0_; e < 128 * 16; e += NTHREADS) { const int r = e >> 4, c8 = (e & 15) * 8; *(LAS u32x4*)(M2s + r * 136 + c8) = *(const u32x4*)(M2 + r * 128 + c8); }
    __syncthreads();
}
DI void f1_item(const bool dry, LAS unsigned char* lds, int item, bf16_t* XC, bf16_t* IM) {
    const int t = tid_opaque(), lane = t & 63, wid = __builtin_amdgcn_readfirstlane(t >> 6), r = lane & 15, q = lane >> 4;
    LAS bf16_t* Fs = (LAS bf16_t*)lds;
    LAS bf16_t* M2s = Fs + 256 * 136;
    LAS bf16_t* Z1T = M2s + 128 * 136;
    const bool latent = item < 2048;
    int row0, g;
    if (latent) { const int s = item >> 8, rr = (item >> 2) & 63; g = item & 3; row0 = MCTX + s * 4096 + rr * 64; }
    else { const int it = item - 2048; const int s = it >> 4, tb = (it >> 2) & 3; g = it & 3; row0 = s * 256 + tb * 64; }
    bf16x8 xf[4][4];
#pragma unroll
    for (int mt = 0; mt < 4; ++mt)
#pragma unroll
        for (int ks = 0; ks < 4; ++ks) xf[mt][ks] = *(const bf16x8*)(XC + (size_t)(row0 + mt * 16 + r) * 512 + g * 128 + ks * 32 + q * 8);
    __syncthreads();
    if (latent) {
#pragma unroll
        for (int nn = 0; nn < 2; ++nn) {
            const int nt_ = wid * 2 + nn;
            bf16x8 bfr[4];
#pragma unroll
            for (int ks = 0; ks < 4; ++ks) bfr[ks] = *(const LAS bf16x8*)(Fs + (nt_ * 16 + r) * 136 + ks * 32 + q * 8);
#pragma unroll
            for (int mt = 0; mt < 4; ++mt) {
                f32x4 acc = (f32x4){0.f, 0.f, 0.f, 0.f};
#pragma unroll
                for (int ks = 0; ks < 4; ++ks) acc = mfma16(xf[mt][ks], bfr[ks], acc);
                u32x2 w; w.x = pk2(acc[0], acc[1]); w.y = pk2(acc[2], acc[3]);
                *(LAS u32x2*)(Z1T + (nt_ * 16 + r) * 72 + mt * 16 + q * 4) = w;
            }
        }
        __syncthreads();
        bf16x8 af[4];
#pragma unroll
        for (int ks = 0; ks < 4; ++ks) { const int nrow = (ks < 2 ? 0 : 128) + wid * 16 + r; af[ks] = *(const LAS bf16x8*)(Z1T + nrow * 72 + (ks & 1) * 32 + q * 8); }
#pragma unroll 1
        for (int ct = 0; ct < 8; ++ct) {
            f32x4 acc = (f32x4){0.f, 0.f, 0.f, 0.f};
#pragma unroll
            for (int ks = 0; ks < 4; ++ks) { const bf16x8 b = *(const LAS bf16x8*)(M2s + (ct * 16 + r) * 136 + ks * 32 + q * 8); acc = mfma16(af[ks], b, acc); }
            const int c2p = ct * 16 + r;
            bf16_t* dst = (c2p < 64) ? XC : IM;
            u32x2 w; w.x = pk2(acc[0], acc[1]); w.y = pk2(acc[2], acc[3]);
            if (!dry) *(u32x2*)(dst + (size_t)(row0 + (c2p & 63)) * 512 + g * 128 + wid * 16 + q * 4) = w;
        }
    } else {
#pragma unroll
        for (int nn = 0; nn < 2; ++nn) {
            const int nt_ = wid * 2 + nn;
            bf16x8 afr[4];
#pragma unroll
            for (int ks = 0; ks < 4; ++ks) afr[ks] = *(const LAS bf16x8*)(Fs + (nt_ * 16 + r) * 136 + ks * 32 + q * 8);
#pragma unroll
            for (int mt = 0; mt < 4; ++mt) {
                f32x4 acc = (f32x4){0.f, 0.f, 0.f, 0.f};
#pragma unroll
                for (int ks = 0; ks < 4; ++ks) acc = mfma16(afr[ks], xf[mt][ks], acc);
                const int n = nt_ * 16 + q * 4;
                bf16_t* dst = (n < 128) ? XC : IM;
                u32x2 w; w.x = pk2(acc[0], acc[1]); w.y = pk2(acc[2], acc[3]);
                if (!dry) *(u32x2*)(dst + (size_t)(row0 + mt * 16 + r) * 512 + g * 128 + (n & 127)) = w;
            }
        }
    }
    __syncthreads();
}

DI void f3_latent_item(const bool dry, LAS unsigned char* lds, int item, bf16_t* XC, const bf16_t* IM, const bf16_t* ZC) {
    const int t = tid_opaque(), lane = t & 63, wid = __builtin_amdgcn_readfirstlane(t >> 6), r = lane & 15, q = lane >> 4;
    LAS bf16_t* CSs = (LAS bf16_t*)lds;
    LAS bf16_t* ZT = CSs + 64 * 136;
    const int s = item >> 8, g = (item >> 6) & 3, c2 = item & 63;
    const int tok0 = MCTX + s * 4096 + c2;
#pragma unroll
    for (int i = 0; i < 4; ++i) {
        const int e = t + i * NTHREADS, kk = e >> 4, c8 = (e & 15) * 8;
        const bf16_t* src = (kk < 64 ? XC : IM) + (size_t)(tok0 + (kk & 63) * 64) * 512 + g * 128 + c8;
        const u32x4 x = *(const u32x4*)src;
        const unsigned v[4] = {x.x, x.y, x.z, x.w};
#pragma unroll
        for (int p = 0; p < 4; ++p) { ZT[(c8 + 2 * p) * 136 + kk] = (bf16_t)(v[p] & 0xffffu); ZT[(c8 + 2 * p + 1) * 136 + kk] = (bf16_t)(v[p] >> 16); }
    }
    __syncthreads();
    const float nrm = 0.0013810679320049757f;
#pragma unroll 1
    for (int rt = 0; rt < 4; ++rt) {
        f32x4 acc = (f32x4){0.f, 0.f, 0.f, 0.f};
        acc = mma_tile(acc, ZT + wid * 16 * 136, 136, CSs + rt * 16 * 136, 136, 128, lane);
        const size_t off = (size_t)(tok0 + (rt * 16 + r) * 64) * 512 + g * 128 + wid * 16 + q * 4;
        const u32x2 z = *(const u32x2*)(ZC + off);
        u32x2 w; w.x = pk2(acc[0] * nrm * bflo(z.x), acc[1] * nrm * bfhi(z.x)); w.y = pk2(acc[2] * nrm * bflo(z.y), acc[3] * nrm * bfhi(z.y));
        if (!dry) *(u32x2*)(XC + off) = w;
    }
    __syncthreads();
}
DI void f3_context_item(const bool dry, LAS unsigned char* lds, int item, bf16_t* XC, const bf16_t* IM, const bf16_t* ZC, const bf16_t* CS256, bf16_t* OUT) {
    const int t = tid_opaque(), lane = t & 63, wid = __builtin_amdgcn_readfirstlane(t >> 6), r = lane & 15, q = lane >> 4;
    LAS bf16_t* ZT = (LAS bf16_t*)lds;
    const int s = item >> 4, g = (item >> 2) & 3, qt = item & 3, tok0 = s * 256;
    const int tt = qt * 4 + (wid >> 1), m0 = (wid & 1) * 4;
    bf16x8 bfr[16];
#pragma unroll
    for (int ks = 0; ks < 16; ++ks) bfr[ks] = *(const bf16x8*)(CS256 + (size_t)(tt * 16 + r) * 512 + ks * 32 + q * 8);
    for (int e = t; e < 512 * 16; e += NTHREADS) {
        const int kk = e >> 4, c8 = (e & 15) * 8;
        const bf16_t* src = (kk < 256 ? XC : IM) + (size_t)(tok0 + (kk & 255)) * 512 + g * 128 + c8;
        const u32x4 x = *(const u32x4*)src;
        const unsigned v[4] = {x.x, x.y, x.z, x.w};
#pragma unroll
        for (int p = 0; p < 4; ++p) { ZT[(c8 + 2 * p) * 520 + kk] = (bf16_t)(v[p] & 0xffffu); ZT[(c8 + 2 * p + 1) * 520 + kk] = (bf16_t)(v[p] >> 16); }
    }
    __syncthreads();
    const float nrm = 0.005524271728019903f;
    f32x4 acc[4];
#pragma unroll
    for (int m = 0; m < 4; ++m) acc[m] = (f32x4){0.f, 0.f, 0.f, 0.f};
#pragma unroll
    for (int ks = 0; ks < 16; ++ks) {
#pragma unroll
        for (int m = 0; m < 4; ++m) { const bf16x8 a = *(const LAS bf16x8*)(ZT + ((m0 + m) * 16 + r) * 520 + ks * 32 + q * 8); acc[m] = mfma16(a, bfr[ks], acc[m]); }
    }
#pragma unroll
    for (int m = 0; m < 4; ++m) {
        const size_t off = (size_t)(tok0 + tt * 16 + r) * 512 + g * 128 + (m0 + m) * 16 + q * 4;
        const u32x2 z = *(const u32x2*)(ZC + off);
        u32x2 w; w.x = pk2(acc[m][0] * nrm * bflo(z.x), acc[m][1] * nrm * bfhi(z.x)); w.y = pk2(acc[m][2] * nrm * bflo(z.y), acc[m][3] * nrm * bfhi(z.y));
        if (!dry) *(u32x2*)(OUT + off) = w;
    }
    __syncthreads();
}

#define LBAR do { asm volatile("s_waitcnt lgkmcnt(0)" ::: "memory"); __builtin_amdgcn_s_barrier(); asm volatile("" ::: "memory"); } while (0)
DI void chain_item(LAS unsigned char* lds, int item, int layer, const bf16_t* QKV, const bf16_t* TQ, const float* GB, bf16_t* OF, bf16_t* OB, const float* state_in, float* state_out) {
    const int t = tid_opaque(), lane = t & 63, wid = __builtin_amdgcn_readfirstlane(t >> 6), r = lane & 15, q = lane >> 4;
    LAS bf16_t* KS = (LAS bf16_t*)lds;
    LAS bf16_t* QS = KS + 64 * 136;
    LAS bf16_t* KT = QS + 64 * 136;
    LAS bf16_t* TS = KT + 128 * 72;
    LAS bf16_t* QKM = TS + 64 * 72;
    LAS bf16_t* ST = QKM + 64 * 72;
    LAS bf16_t* XT = ST + 2 * 32 * 136;
    LAS bf16_t* UT = XT + 32 * 72;
    LAS bf16_t* UDT = UT + 32 * 72;
    LAS float* VBs = (LAS float*)(UDT + 32 * 72);
    LAS float* gam = VBs + 64 * 36;
    LAS float* bet = gam + 64;
    int rs, nch, sidx; bool latent = item < 256;
    const int ii = latent ? item : item - 256;
    const int h = (ii >> 3) & 3, d = (ii >> 2) & 1, vs = ii & 3; sidx = ii >> 5;
    if (latent) { rs = MCTX + sidx * 4096; nch = 64; } else { rs = sidx * 256; nch = 4; }
    bf16_t* O = d ? OB : OF;
    f32x4 sacc[2];
#pragma unroll
    for (int ni = 0; ni < 2; ++ni) {
        if (latent) {
            const float* sp = state_in + ((((size_t)sidx * NLAYER + layer) * 2 + d) * 4 + h) * 16384;
#pragma unroll
            for (int j = 0; j < 4; ++j) sacc[ni][j] = sp[(size_t)(wid * 16 + q * 4 + j) * 128 + vs * 32 + ni * 16 + r];
        } else sacc[ni] = (f32x4){0.f, 0.f, 0.f, 0.f};
        u32x2 w; w.x = pk2(sacc[ni][0], sacc[ni][1]); w.y = pk2(sacc[ni][2], sacc[ni][3]);
        *(LAS u32x2*)(ST + (ni * 16 + r) * 136 + wid * 16 + q * 4) = w;
    }
    const int ki = t >> 3, kseg = (t & 7) * 16;
    const int vi = (t >> 2) & 63, vseg = (t & 3) * 8;
    u32x4 kreg[2], qreg[2], vreg, treg; float gv = 0.f, bv = 0.f, bvv = 0.f;
#define CH_PREFETCH(n) do { const int c_ = d ? nch - 1 - (n) : (n); const int cgl = (rs >> 6) + c_; \
        const size_t orow = (size_t)rs + c_ * 64 + (d ? 63 - ki : ki); \
        kreg[0] = *(const u32x4*)(QKV + orow * 1536 + 512 + h * 128 + kseg); kreg[1] = *(const u32x4*)(QKV + orow * 1536 + 512 + h * 128 + kseg + 8); \
        qreg[0] = *(const u32x4*)(QKV + orow * 1536 + h * 128 + kseg); qreg[1] = *(const u32x4*)(QKV + orow * 1536 + h * 128 + kseg + 8); \
        const size_t base_ = (size_t)(cgl * 4 + h) * 2 + d; \
        treg = *(const u32x4*)(TQ + base_ * 4096 + (size_t)ki * 64 + (t & 7) * 8); \
        if (t < 256) { const size_t vrow = (size_t)rs + c_ * 64 + (d ? 63 - vi : vi); vreg = *(const u32x4*)(QKV + vrow * 1536 + 1024 + h * 128 + vs * 32 + vseg); bvv = GB[base_ * 128 + 64 + vi]; } \
        if (t < 64) { gv = GB[base_ * 128 + t]; bv = GB[base_ * 128 + 64 + t]; } } while (0)
    CH_PREFETCH(0);
    for (int n = 0; n < nch; ++n) {
        const int cur = n & 1;
        LAS bf16_t* STc = ST + cur * 32 * 136; LAS bf16_t* STn = ST + (cur ^ 1) * 32 * 136;
        *(LAS u32x4*)(KS + ki * 136 + kseg) = kreg[0]; *(LAS u32x4*)(KS + ki * 136 + kseg + 8) = kreg[1];
        *(LAS u32x4*)(QS + ki * 136 + kseg) = qreg[0]; *(LAS u32x4*)(QS + ki * 136 + kseg + 8) = qreg[1];
        {
            const unsigned kv[8] = {kreg[0].x, kreg[0].y, kreg[0].z, kreg[0].w, kreg[1].x, kreg[1].y, kreg[1].z, kreg[1].w};
#pragma unroll
            for (int p = 0; p < 8; ++p) { KT[(kseg + 2 * p) * 72 + ki] = (bf16_t)(kv[p] & 0xffffu); KT[(kseg + 2 * p + 1) * 72 + ki] = (bf16_t)(kv[p] >> 16); }
        }
        {
            const int i = ki, j0 = (t & 7) * 8;
            unsigned tv[4] = {treg.x, treg.y, treg.z, treg.w};
#pragma unroll
            for (int p = 0; p < 4; ++p) {
                const int ja = j0 + 2 * p, jb = ja + 1;
                unsigned lo = tv[p] & 0xffffu, hi = tv[p] >> 16;
                if (ja >= i) lo = (ja == i) ? 0x3f80u : 0u;
                if (jb >= i) hi = (jb == i) ? 0x3f80u : 0u;
                tv[p] = lo | (hi << 16);
            }
            *(LAS u32x4*)(TS + i * 72 + j0) = (u32x4){tv[0], tv[1], tv[2], tv[3]};
        }
        if (t < 256) {
            const float vv[8] = {bflo(vreg.x), bfhi(vreg.x), bflo(vreg.y), bfhi(vreg.y), bflo(vreg.z), bfhi(vreg.z), bflo(vreg.w), bfhi(vreg.w)};
            *(LAS f32x4*)(VBs + vi * 36 + vseg) = (f32x4){vv[0] * bvv, vv[1] * bvv, vv[2] * bvv, vv[3] * bvv};
            *(LAS f32x4*)(VBs + vi * 36 + vseg + 4) = (f32x4){vv[4] * bvv, vv[5] * bvv, vv[6] * bvv, vv[7] * bvv};
        }
        if (t < 64) { gam[t] = gv; bet[t] = bv; }
        LBAR;
        if (n + 1 < nch) CH_PREFETCH(n + 1);
        const float glast = gam[63];
#pragma unroll
        for (int tt = 0; tt < 2; ++tt) {
            const int tile = wid * 2 + tt, mi = tile >> 2, ni = tile & 3;
            f32x4 acc = (f32x4){0.f, 0.f, 0.f, 0.f};
            if (ni <= mi) acc = mma_tile(acc, QS + mi * 16 * 136, 136, KS + ni * 16 * 136, 136, 128, lane);
            const int jj = ni * 16 + r; const float gj = gam[jj];
#pragma unroll
            for (int j = 0; j < 4; ++j) { const int i = mi * 16 + q * 4 + j; const float v = (i >= jj) ? acc[j] * __expf(gam[i] - gj) : 0.f; QKM[i * 72 + jj] = (bf16_t)f2bf(v); }
        }
        const int mi = wid >> 1, ni = wid & 1;
        {
            f32x4 acc = (f32x4){0.f, 0.f, 0.f, 0.f};
            acc = mma_tile(acc, KS + mi * 16 * 136, 136, STc + ni * 16 * 136, 136, 128, lane);
            float x[4];
#pragma unroll
            for (int j = 0; j < 4; ++j) { const int i = mi * 16 + q * 4 + j; x[j] = VBs[i * 36 + ni * 16 + r] - bet[i] * __expf(gam[i]) * acc[j]; }
            u32x2 w; w.x = pk2(x[0], x[1]); w.y = pk2(x[2], x[3]);
            *(LAS u32x2*)(XT + (ni * 16 + r) * 72 + mi * 16 + q * 4) = w;
        }
        LBAR;
        {
            f32x4 acc = (f32x4){0.f, 0.f, 0.f, 0.f};
            acc = mma_tile(acc, TS + mi * 16 * 72, 72, XT + ni * 16 * 72, 72, 64, lane);
            float ud[4];
#pragma unroll
            for (int j = 0; j < 4; ++j) { const int i = mi * 16 + q * 4 + j; ud[j] = acc[j] * __expf(glast - gam[i]); }
            u32x2 w; w.x = pk2(acc[0], acc[1]); w.y = pk2(acc[2], acc[3]);
            *(LAS u32x2*)(UT + (ni * 16 + r) * 72 + mi * 16 + q * 4) = w;
            u32x2 w2; w2.x = pk2(ud[0], ud[1]); w2.y = pk2(ud[2], ud[3]);
            *(LAS u32x2*)(UDT + (ni * 16 + r) * 72 + mi * 16 + q * 4) = w2;
        }
        LBAR;
        {
            f32x4 acc = (f32x4){0.f, 0.f, 0.f, 0.f};
            acc = mma_tile(acc, QS + mi * 16 * 136, 136, STc + ni * 16 * 136, 136, 128, lane);
#pragma unroll
            for (int j = 0; j < 4; ++j) acc[j] *= __expf(gam[mi * 16 + q * 4 + j]);
            acc = mma_tile(acc, QKM + mi * 16 * 72, 72, UT + ni * 16 * 72, 72, 64, lane);
            const int c_ = d ? nch - 1 - n : n;
#pragma unroll
            for (int j = 0; j < 4; ++j) { const int i = mi * 16 + q * 4 + j; const size_t orow = (size_t)rs + c_ * 64 + (d ? 63 - i : i);
                O[orow * 512 + h * 128 + vs * 32 + ni * 16 + r] = (bf16_t)f2bf(acc[j]); }
        }
        {
            const float gl = __expf(glast);
#pragma unroll
            for (int n2 = 0; n2 < 2; ++n2) {
                sacc[n2] = sacc[n2] * gl;
                sacc[n2] = mma_tile(sacc[n2], KT + wid * 16 * 72, 72, UDT + n2 * 16 * 72, 72, 64, lane);
                u32x2 w; w.x = pk2(sacc[n2][0], sacc[n2][1]); w.y = pk2(sacc[n2][2], sacc[n2][3]);
                *(LAS u32x2*)(STn + (n2 * 16 + r) * 136 + wid * 16 + q * 4) = w;
            }
        }
        LBAR;
    }
#undef CH_PREFETCH
    if (!latent) {
        float* sp = state_out + ((((size_t)sidx * NLAYER + layer) * 2 + d) * 4 + h) * 16384;
#pragma unroll
        for (int n2 = 0; n2 < 2; ++n2)
#pragma unroll
            for (int j = 0; j < 4; ++j) sp[(size_t)(wid * 16 + q * 4 + j) * 128 + vs * 32 + n2 * 16 + r] = sacc[n2][j];
    }
}

__global__ void __launch_bounds__(NTHREADS) mega_fwd(Params P) {
    extern __shared__ __attribute__((aligned(16))) unsigned char lds_raw[];
    LAS unsigned char* lds = (LAS unsigned char*)lds_raw;
    cg::grid_group grid = cg::this_grid();
    const int G = gridDim.x, bx = blockIdx.x, NGW = G * 8;
    const int xcc = (int)(__builtin_amdgcn_s_getreg((3 << 11) | 20) & 0xFu);
    int myrank = 0, cvirt = bx;
    bool fastbar = false;
#pragma unroll 1
    for (int step0 = -2 * DUP_P0; step0 < 27; ++step0) {
        const int step = step0 < 0 ? step0 + 2 : step0;
        const int kind = step < 2 ? step : (step == 26 ? 8 : 2 + (step - 2) % 6);
        const int l = step < 2 ? 0 : (step == 26 ? 3 : (step - 2) / 6);
        const int t = tid_opaque(), lane = t & 63, wid = __builtin_amdgcn_readfirstlane(t >> 6), gw = bx * 8 + wid;
        unsigned char* ws = P.ws;
        float* out = P.out;
        bf16_t* HS = (bf16_t*)(ws + ((l & 1) ? OFF_Y : OFF_X));
        bf16_t* OTH = (bf16_t*)(ws + ((l & 1) ? OFF_X : OFF_Y));
        if (kind == 0) {
            const float* c_ctx = P.in[4]; const float* cvec = P.in[3];
            LAS float* in_s = (LAS float*)lds; LAS float* red = in_s + 9 * 1024;
            for (int e = t; e < 9 * 1024; e += NTHREADS) { const int j = e >> 10, dd = e & 1023; const float c = (j == 0) ? c_ctx[dd] : cvec[(j - 1) * 1024 + dd]; in_s[e] = silu(c); }
            __syncthreads();
            for (int it = bx; it < 4 * 48; it += G) { const int ll = it / 48, nb = it % 48;
                gemv9_item(in_s, red, P.in[6] + (size_t)ll * 1024 * 3072, 3072, 0, P.in[7] + ll * 3072, (float*)(ws + OFF_MOD) + (size_t)ll * 9 * 3072, 3072, nb * 64); }
            __syncthreads();
            float* ROWSQ = (float*)(ws + OFF_ROWSQ);
            if (bx == 0) { ((unsigned*)(ws + OFF_CTR))[t] = 0u; ((unsigned*)(ws + OFF_CTR))[t + 512] = 0u; }
            for (int e = bx * NTHREADS + t; e < 5 * MTOT; e += G * NTHREADS) ROWSQ[e] = 0.f;
            bf16_t* TAB = (bf16_t*)(ws + OFF_TAB);
            for (int e = bx * NTHREADS + t; e < 188416; e += G * NTHREADS) {
                float v;
                if (e < 32768) { const int n = e >> 7, ch = e & 127; const int m = ((n & 127) * ch) & 127; v = (n < 128) ? cospif(m * (2.0f / 128.0f)) : -sinpif(m * (2.0f / 128.0f)); }
                else if (e < 49152) { const int i = e - 32768, rr = i >> 7, kk = i & 127; const int m = ((rr & 63) * (kk & 63)) & 63; const float c = cospif(m * (2.0f / 64.0f)), sn = sinpif(m * (2.0f / 64.0f));
                    v = (rr < 64) ? (kk < 64 ? c : sn) : (kk < 64 ? -sn : c); }
                else if (e < 57344) { const int i = e - 49152, rr = i >> 7, kk = i & 127; const int m = (rr * (kk & 63)) & 63; v = (kk < 64) ? cospif(m * (2.0f / 64.0f)) : sinpif(m * (2.0f / 64.0f)); }
                else { const int i = e - 57344, rr = i >> 9, kk = i & 511; const int m = (rr * (kk & 255)) & 255; v = (kk < 256) ? cospif(m * (2.0f / 256.0f)) : sinpif(m * (2.0f / 256.0f)); }
                TAB[e] = (bf16_t)f2bf(v);
            }
            __syncthreads();
            transpose_seg(P.in[8], NIN, 1024, (bf16_t*)(ws + OFF_W1), N1, 1, (LAS float*)(lds + wid * 16384), gw, NGW, lane);
        } else if (kind == 1) {
            const float* w_in = P.in[8];
            float* MOD = (float*)(ws + OFF_MOD);
            {
                volatile LAS unsigned* rk = (volatile LAS unsigned*)(lds + 140000);
                if (t == 0) rk[0] = atomicAdd((unsigned*)(ws + OFF_CTR) + xcc, 1u);
                __syncthreads();
                myrank = __builtin_amdgcn_readfirstlane((int)rk[0]);
            }
            LAS float* in_s = (LAS float*)lds; LAS float* red = in_s + 9 * 1024;
            for (int it = bx; it < 4 * 124; it += G) {
                const int ll = it / 124, nb = it % 124;
                __syncthreads();
                for (int e = t; e < 9 * 1024; e += NTHREADS) { const int j = e >> 10, dd = e & 1023; in_s[e] = MOD[((size_t)ll * 9 + j) * 3072 + dd]; }
                __syncthreads();
                if (nb < 76) gemv9_item(in_s, red, w_in + (size_t)ll * 1024 * NIN, NIN, 1, nullptr, (float*)(ws + OFF_SW1) + (size_t)ll * 9 * N1, N1, nb * 64);
                else gemv9_item(in_s, red, w_in + (size_t)ll * 1024 * NIN, NIN, 2, nullptr, (float*)(ws + OFF_SWG) + (size_t)ll * 9 * NGATE, NGATE, (nb - 76) * 64);
            }
            bf16_t* HS0 = (bf16_t*)(ws + OFF_X);
            float* ROWSQ = (float*)(ws + OFF_ROWSQ);
            const float* x_prompt = P.in[0]; const float* x_sample = P.in[1]; const float* ln_g = P.in[5];
            for (int row = gw; row < MTOT; row += NGW) {
                const float* xr = row < MCTX ? x_prompt + (size_t)row * DM : x_sample + (size_t)(row - MCTX) * DM;
                const int bidx = bidx_of_row(row);
                f32x4 v[4]; float sq = 0.f;
#pragma unroll
                for (int j = 0; j < 4; ++j) { v[j] = *(const f32x4*)(xr + j * 256 + lane * 4); sq += (v[j][0] * v[j][0] + v[j][1] * v[j][1]) + (v[j][2] * v[j][2] + v[j][3] * v[j][3]); }
#pragma unroll
                for (int o = 1; o < 64; o <<= 1) sq += __shfl_xor(sq, o);
                if (lane == 0) ROWSQ[row] = sq;
#pragma unroll
                for (int j = 0; j < 4; ++j) { const int col = j * 256 + lane * 4;
                    const f32x4 lg = *(const f32x4*)(ln_g + col); const f32x4 sc = *(const f32x4*)(MOD + (size_t)bidx * 3072 + 1024 + col);
                    const f32x4 y = v[j] * lg * (sc + 1.0f); u32x2 w; w.x = pk2(y[0], y[1]); w.y = pk2(y[2], y[3]); *(u32x2*)(HS0 + (size_t)row * DM + col) = w; }
            }
        } else if (kind == 3) {
            LAS float* scr = (LAS float*)(lds + wid * 16384);
            const float* w_in = P.in[8];
            if (l == 0) {
                transpose_seg(w_in, NIN, 1024, (bf16_t*)(ws + OFF_WG), NGATE, 2, scr, gw, NGW, lane);
                for (int b = 0; b < 3; ++b) transpose_seg(P.in[16] + (size_t)b * 512 * 1024, 1024, 512, (bf16_t*)(ws + OFF_WBR) + (size_t)b * 1024 * 512, 1024, 0, scr, gw, NGW, lane);
            }
            transpose_seg(P.in[17] + (size_t)l * 1024 * 1024, 1024, 1024, (bf16_t*)(ws + OFF_WOUT), 1024, 0, scr, gw, NGW, lane);
            __syncthreads();
            const bool dryrt = (P.out != nullptr);
            for (int rep = (DUP_BI ? 0 : 1); rep < 2; ++rep) {
                const bool dry = (rep == 0) && dryrt;
                for (int it = bx; it < 2304; it += G) d1_item(dry, lds, it, (bf16_t*)(ws + OFF_QKV), (const bf16_t*)(ws + OFF_HALO), (const float*)(ws + OFF_BD), P.in[9] + (size_t)l * 3 * 1536, (float*)(ws + OFF_GB), (bf16_t*)(ws + OFF_TQ), P.in[10] + l * 8, P.in[11] + l * 8);
                for (int it = bx; it < 1152; it += G) sgu_item(dry, lds, it, OTH, (bf16_t*)(ws + OFF_UBZ), P.in[13] + l * 512, P.in[14] + (size_t)l * 4 * 16384, P.in[15] + l * 512);
                f1_load_tables(lds, (const bf16_t*)(ws + OFF_TAB));
                for (int it = bx; it < 2304; it += G) f1_item(dry, lds, it, (bf16_t*)(ws + OFF_XC), (bf16_t*)(ws + OFF_IM));
            }
        } else if (kind == 4) {
            bf16_t* OF = OTH; bf16_t* OB = OTH + (size_t)MTOT * 512;
            for (int rep = 0; rep < (DUP_CHAIN ? 2 : 1); ++rep)
            for (int it = bx; it < 768; it += G) { chain_item(lds, it, l, (const bf16_t*)(ws + OFF_QKV), (const bf16_t*)(ws + OFF_TQ), (const float*)(ws + OFF_GB), OF, OB, P.in[2], out + (size_t)MTOT * DM); __syncthreads(); }
            {
                LAS bf16_t* CSs = (LAS bf16_t*)lds; const bf16_t* CS64 = (const bf16_t*)(ws + OFF_TAB) + TAB_CS64 / 2;
                for (int e = t; e < 64 * 16; e += NTHREADS) { const int rr = e >> 4, c8 = (e & 15) * 8; *(LAS u32x4*)(CSs + rr * 136 + c8) = *(const u32x4*)(CS64 + rr * 128 + c8); }
                __syncthreads();
            }
            const bool dryrt = (P.out != nullptr);
            for (int rep = (DUP_F3 ? 0 : 1); rep < 2; ++rep) {
                const bool dry = (rep == 0) && dryrt;
                for (int it = bx; it < 2048; it += G) f3_latent_item(dry, lds, it, (bf16_t*)(ws + OFF_XC), (const bf16_t*)(ws + OFF_IM), (const bf16_t*)(ws + OFF_ZC));
                for (int it = bx; it < 256; it += G) f3_context_item(dry, lds, it, (bf16_t*)(ws + OFF_XC), (const bf16_t*)(ws + OFF_IM), (const bf16_t*)(ws + OFF_ZC), (const bf16_t*)(ws + OFF_TAB) + TAB_CS256 / 2, (bf16_t*)(ws + OFF_SPARE));
            }
        } else if (kind == 8) {
            const float* rowsq = (const float*)(ws + OFF_ROWSQ) + (size_t)4 * MTOT; const float* final_g = P.in[18];
            for (int row = gw; row < MTOT; row += NGW) {
                const float ri = rsqrtf(rowsq[row] * (1.0f / DM) + EPS);
#pragma unroll
                for (int j = 0; j < 4; ++j) { const int col = j * 256 + lane * 4; float* p = out + (size_t)row * DM + col;
                    const f32x4 v = *(const f32x4*)p; const f32x4 g = *(const f32x4*)(final_g + col); *(f32x4*)p = v * ri * g; }
            }
        } else {
            if (kind == 5) {
                const bf16_t* OF = OTH; const bf16_t* OB = OTH + (size_t)MTOT * 512; bf16_t* ZA = (bf16_t*)(ws + OFF_ZA);
                const float* og = P.in[12] + l * 128;
                for (int row = gw; row < MCTX; row += NGW) *(u32x4*)((bf16_t*)(ws + OFF_XC) + (size_t)row * 512 + lane * 8) = *(const u32x4*)((const bf16_t*)(ws + OFF_SPARE) + (size_t)row * 512 + lane * 8);
                for (int row = gw; row < MTOT; row += NGW) {
                    const size_t off = (size_t)row * 512 + lane * 8;
                    const u32x4 a = *(const u32x4*)(OF + off), b = *(const u32x4*)(OB + off), z = *(const u32x4*)(ZA + off);
                    f32x4 o0 = (f32x4){bflo(a.x) + bflo(b.x), bfhi(a.x) + bfhi(b.x), bflo(a.y) + bflo(b.y), bfhi(a.y) + bfhi(b.y)};
                    f32x4 o1 = (f32x4){bflo(a.z) + bflo(b.z), bfhi(a.z) + bfhi(b.z), bflo(a.w) + bflo(b.w), bfhi(a.w) + bfhi(b.w)};
                    float sq = (o0[0] * o0[0] + o0[1] * o0[1]) + (o0[2] * o0[2] + o0[3] * o0[3]) + (o1[0] * o1[0] + o1[1] * o1[1]) + (o1[2] * o1[2] + o1[3] * o1[3]);
                    sq += __shfl_xor(sq, 1); sq += __shfl_xor(sq, 2); sq += __shfl_xor(sq, 4); sq += __shfl_xor(sq, 8);
                    const float ri = rsqrtf(sq * (1.0f / 128.0f) + EPS);
                    const int c0 = (lane & 15) * 8;
                    const f32x4 g0 = *(const f32x4*)(og + c0), g1 = *(const f32x4*)(og + c0 + 4);
                    const f32x4 z0 = (f32x4){bflo(z.x), bfhi(z.x), bflo(z.y), bfhi(z.y)}, z1 = (f32x4){bflo(z.z), bfhi(z.z), bflo(z.w), bfhi(z.w)};
                    o0 = o0 * ri * g0 * z0; o1 = o1 * ri * g1 * z1;
                    u32x4 w; w.x = pk2(o0[0], o0[1]); w.y = pk2(o0[2], o0[3]); w.z = pk2(o1[0], o1[1]); w.w = pk2(o1[2], o1[3]);
                    *(u32x4*)(ZA + off) = w;
                }
                __syncthreads();
            }
            if (step == 2) {
                const unsigned* ctr = (const unsigned*)(ws + OFF_CTR);
                bool ok = (G % 8) == 0 && xcc < 8;
                for (int j = 0; j < 8; ++j) ok = ok && ((int)__hip_atomic_load(ctr + j, __ATOMIC_RELAXED, __HIP_MEMORY_SCOPE_AGENT) == G / 8);
                cvirt = ok ? myrank * 8 + xcc : bx;
                fastbar = ok;
            }
            pg8::Sched S; S.nM = MTOT / 256; S.G = G; S.c = cvirt; S.nsub = 1; S.K = 1024; S.bsub = 0;
            S.A0 = (const char*)HS; S.asub = 0;
            EpiAll E; E.layer = l; E.ws = ws; E.out = out; E.xp = P.in[0]; E.xs = P.in[1];
            E.lng_next = P.in[5] + (size_t)(l + 1 < NLAYER ? l + 1 : l) * DM; E.hs = HS; E.oth = OTH;
            if (kind == 2) { E.mode = 0; S.nN = N1 / 256; S.B0 = (const char*)(ws + OFF_W1); }
            else if (kind == 5) { E.mode = 1; S.nN = NGATE / 256; S.B0 = (const char*)(ws + OFF_WG); }
            else if (kind == 6) { E.mode = 2; S.nN = 4; S.nsub = 3; S.K = 512; S.A0 = (const char*)(ws + OFF_ZA); S.asub = RB;
                S.B0 = (const char*)(ws + OFF_WBR); S.bsub = (size_t)1024 * 512 * 2; }
            else { E.mode = 3; S.nN = 4; S.B0 = (const char*)(ws + OFF_WOUT); }
            S.nwg = S.nM * S.nN;
            S.pre = (kind == 2 || kind == 5);
            S.pre_rq = (const float*)(ws + OFF_ROWSQ) + (size_t)l * MTOT;
            S.pre_sw = (kind == 2) ? (const float*)(ws + OFF_SW1) + (size_t)l * 9 * N1 : (const float*)(ws + OFF_SWG) + (size_t)l * 9 * NGATE;
            S.pre_ld = (kind == 2) ? N1 : NGATE;
            for (int rep = ((DUP_GEMM && kind != 7) ? 0 : 1); rep < 2; ++rep) { E.dry = (rep == 0) && (P.out != nullptr); pg8::gemm_phase<EpiAll>(lds, S, E); __syncthreads(); }
            if ((kind == 6 || kind == 7) && l + 1 < NLAYER) {
                const int rem = S.nwg % G;
                const bool light = (rem == 0) || (cvirt >= rem);
                if (light) {
                    const int lgw = (rem == 0 ? cvirt : cvirt - rem) * 8 + wid, LNGW = (rem == 0 ? G : G - rem) * 8;
                    LAS float* scr = (LAS float*)(lds + wid * 16384);
                    if (kind == 6) {
                        transpose_seg(P.in[8] + (size_t)(l + 1) * 1024 * NIN, NIN, 1024, (bf16_t*)(ws + OFF_W1), N1, 1, scr, lgw, LNGW, lane);
                        transpose_seg(P.in[8] + (size_t)(l + 1) * 1024 * NIN, NIN, 1024, (bf16_t*)(ws + OFF_WG), NGATE, 2, scr, lgw, LNGW, lane);
                    } else {
                        for (int b = 0; b < 3; ++b) transpose_seg(P.in[16] + ((size_t)(l + 1) * 3 + b) * 512 * 1024, 1024, 512, (bf16_t*)(ws + OFF_WBR) + (size_t)b * 1024 * 512, 1024, 0, scr, lgw, LNGW, lane);
                    }
                }
            }
        }
        if (!fastbar) grid.sync();
        else {
            unsigned* ctr = (unsigned*)(P.ws + OFF_CTR);
            asm volatile("s_waitcnt vmcnt(0)" ::: "memory");
            __syncthreads();
            if (threadIdx.x == 0) {
                const unsigned nloc = (unsigned)(G / 8);
                unsigned* xsub = ctr + 128 + 32 * xcc; unsigned* xgen = ctr + 384 + 32 * xcc; unsigned* top = ctr + 640; unsigned* topgen = ctr + 672;
                const unsigned old = __hip_atomic_fetch_add(xsub, 1u, __ATOMIC_RELAXED, __HIP_MEMORY_SCOPE_AGENT);
                const unsigned gen = old / nloc;
                if (old + 1u == (gen + 1u) * nloc) {
                    __builtin_amdgcn_fence(__ATOMIC_RELEASE, "agent");
                    asm volatile("s_waitcnt vmcnt(0)" ::: "memory");
                    const unsigned og = __hip_atomic_fetch_add(top, 1u, __ATOMIC_RELAXED, __HIP_MEMORY_SCOPE_AGENT);
                    const unsigned tg = og / 8u;
                    if (og + 1u == (tg + 1u) * 8u) __hip_atomic_fetch_add(topgen, 1u, __ATOMIC_RELAXED, __HIP_MEMORY_SCOPE_AGENT);
                    else { while (__hip_atomic_load(topgen, __ATOMIC_RELAXED, __HIP_MEMORY_SCOPE_AGENT) == tg) __builtin_amdgcn_s_sleep(1); }
                    __builtin_amdgcn_fence(__ATOMIC_ACQUIRE, "agent");
                    __hip_atomic_fetch_add(xgen, 1u, __ATOMIC_RELAXED, __HIP_MEMORY_SCOPE_AGENT);
                    asm volatile("s_waitcnt vmcnt(0)" ::: "memory");
                } else {
                    while (__hip_atomic_load(xgen, __ATOMIC_RELAXED, __HIP_MEMORY_SCOPE_AGENT) == gen) __builtin_amdgcn_s_sleep(1);
                    __builtin_amdgcn_fence(__ATOMIC_ACQUIRE, "agent");
                    asm volatile("s_waitcnt vmcnt(0)" ::: "memory");
                }
            }
            __syncthreads();
        }
    }
}

extern "C" void kernel_launch(void* const* d_in, const int* in_sizes, int n_in, void* d_out, int out_size, void* d_ws, size_t ws_size, hipStream_t stream) {
    static int grid_blocks = 0;
    if (grid_blocks == 0) {
        if (n_in != 19 || ws_size < WS_END) { fprintf(stderr, "kernel_launch: unexpected inputs (n_in %d, ws %zu, need %zu)\n", n_in, ws_size, (size_t)WS_END); grid_blocks = -1; return; }
        int dev = 0, cus = 0, per_cu = 0;
        hipGetDevice(&dev);
        hipDeviceGetAttribute(&cus, hipDeviceAttributeMultiprocessorCount, dev);
        if (hipFuncSetAttribute((const void*)mega_fwd, hipFuncAttributeMaxDynamicSharedMemorySize, LDS_BYTES) != hipSuccess) { fprintf(stderr, "kernel_launch: hipFuncSetAttribute failed\n"); grid_blocks = -1; return; }
        if (hipOccupancyMaxActiveBlocksPerMultiprocessor(&per_cu, (const void*)mega_fwd, NTHREADS, LDS_BYTES) != hipSuccess || per_cu < 1) { fprintf(stderr, "kernel_launch: occupancy query gave %d\n", per_cu); per_cu = 1; }
        (void)hipGetLastError();
        grid_blocks = cus * per_cu;
    }
    if (grid_blocks < 0) return;
    Params p{};
    for (int i = 0; i < 19; ++i) p.in[i] = (const float*)d_in[i];
    p.out = (float*)d_out; p.ws = (unsigned char*)d_ws;
    void* args[] = {&p};
    hipError_t e = hipLaunchCooperativeKernel((const void*)mega_fwd, dim3(grid_blocks), dim3(NTHREADS), args, LDS_BYTES, stream);
    if (e != hipSuccess) fprintf(stderr, "cooperative launch failed: %s (grid %d)\n", hipGetErrorString(e), grid_blocks);
}
```
